# Optimizing an MI355X kernel written in HIP

```python
import jax
import jax.numpy as jnp
from jax import lax
import numpy as np

D_MODEL = 1024
BATCH = 2
SEQ = 16384
DEPTH = 2

N_MIXERS = 2
PLE_DIM = 256
D_FF = 2816
NORM_EPS = 1e-6
ROPE_THETA = 10000.0

NSA_HEADS = 16
NSA_KV_GROUPS = 4
NSA_HEAD_DIM = D_MODEL // NSA_HEADS
CMP_BLOCK = 32
CMP_STRIDE = 16
SEL_BLOCK = 64
N_SELECT = 16
WINDOW = 512
Q_BLOCK = 128
NSA_Q_COLS = NSA_HEADS * NSA_HEAD_DIM
NSA_KV_COLS = NSA_KV_GROUPS * NSA_HEAD_DIM
NSA_IN_COLS = NSA_Q_COLS + 6 * NSA_KV_COLS + 3 * NSA_HEADS

HGRN_EXPAND = 128
HGRN_HEADS = D_MODEL // HGRN_EXPAND
HGRN_DK = HGRN_EXPAND
HGRN_DV = D_MODEL // HGRN_HEADS
HGRN_CHUNK = 64
HGRN_IN_COLS = 2 * HGRN_HEADS * HGRN_DK + 2 * HGRN_HEADS * HGRN_DV

kernel_name = "hybrid_nsa_hgrn2_macaron_block"


def rms_norm(x, gain):
    xf = x.astype(jnp.float32)
    y = xf * lax.rsqrt(jnp.mean(xf * xf, axis=-1, keepdims=True) + NORM_EPS)
    return (y * gain.astype(jnp.float32)).astype(x.dtype)


def rope(x, pos):
    half = x.shape[-1] // 2
    inv = ROPE_THETA ** (-jnp.arange(half, dtype=jnp.float32) / half)
    ang = pos.astype(jnp.float32)[:, None] * inv[None, :]
    cos = jnp.cos(ang)[None, :, None, :]
    sin = jnp.sin(ang)[None, :, None, :]
    x1 = x[..., :half].astype(jnp.float32)
    x2 = x[..., half:].astype(jnp.float32)
    return jnp.concatenate([x1 * cos - x2 * sin, x2 * cos + x1 * sin], axis=-1).astype(x.dtype)


def masked_softmax(s, mask):
    s = jnp.where(mask, s.astype(jnp.float32), -jnp.inf)
    m = jnp.max(s, axis=-1, keepdims=True)
    m = jnp.where(jnp.isfinite(m), m, 0.0)
    e = jnp.exp(s - m)
    return e / jnp.maximum(jnp.sum(e, axis=-1, keepdims=True), 1e-30)


def swiglu(x, w_in, w_out):
    g, u = jnp.split(x @ w_in, 2, axis=-1)
    return (jax.nn.silu(g) * u) @ w_out


def compress_blocks(kv, pos_enc, w1, w2):
    b, s, g, d = kv.shape
    ratio = CMP_BLOCK // CMP_STRIDE
    n_cmp = s // CMP_STRIDE - ratio + 1
    c = kv.reshape(b, s // CMP_STRIDE, CMP_STRIDE, g, d)
    blocks = jnp.concatenate([c[:, r:r + n_cmp] for r in range(ratio)], axis=2)
    blocks = blocks + pos_enc[:, None, :].astype(kv.dtype)
    flat = blocks.transpose(0, 1, 3, 2, 4).reshape(b, n_cmp, g, CMP_BLOCK * d)
    return jax.nn.silu(flat @ w1) @ w2


def selection_importance(p_cmp, n_sel):
    r = SEL_BLOCK // CMP_STRIDE
    lo = -(CMP_BLOCK // CMP_STRIDE - 1)
    hi = r - 1
    n_cmp = p_cmp.shape[-1]
    pad = [(0, 0)] * (p_cmp.ndim - 1) + [(-lo, r * n_sel + hi + 1 - n_cmp)]
    pp = jnp.pad(p_cmp, pad)
    return sum(pp[..., o - lo:o - lo + r * n_sel:r] for o in range(lo, hi + 1))


def nsa_mixer(h, w_in, w_out, cmp_pos, cmp_w1, cmp_w2):
    b, s, _ = h.shape
    H, G, D = NSA_HEADS, NSA_KV_GROUPS, NSA_HEAD_DIM
    HG = H // G
    splits = [NSA_Q_COLS + i * NSA_KV_COLS for i in range(7)]
    q, k_c, v_c, k_s, v_s, k_w, v_w, gates = jnp.split(h @ w_in, splits, axis=-1)
    pos = jnp.arange(s)
    q = rope(q.reshape(b, s, H, D), pos) * (D ** -0.5)
    k_c, k_s, k_w = [rope(t.reshape(b, s, G, D), pos) for t in (k_c, k_s, k_w)]
    v_c, v_s, v_w = [t.reshape(b, s, G, D) for t in (v_c, v_s, v_w)]
    gates = jax.nn.sigmoid(gates.astype(jnp.float32)).reshape(b, s, H, 3)

    k_cmp = compress_blocks(k_c, cmp_pos[0], cmp_w1[0], cmp_w2[0])
    v_cmp = compress_blocks(v_c, cmp_pos[1], cmp_w1[1], cmp_w2[1])
    n_cmp = k_cmp.shape[1]
    cmp_end = jnp.arange(n_cmp) * CMP_STRIDE + CMP_BLOCK - 1

    n_sel = s // SEL_BLOCK
    top_n = min(N_SELECT, n_sel)
    k_sel = k_s.reshape(b, n_sel, SEL_BLOCK, G, D).transpose(0, 3, 1, 2, 4)
    v_sel = v_s.reshape(b, n_sel, SEL_BLOCK, G, D).transpose(0, 3, 1, 2, 4)
    blk = jnp.arange(n_sel)
    bi = jnp.arange(b)[:, None, None, None]
    gi = jnp.arange(G)[None, :, None, None]

    k_win = jnp.pad(k_w, ((0, 0), (WINDOW, 0), (0, 0), (0, 0)))
    v_win = jnp.pad(v_w, ((0, 0), (WINDOW, 0), (0, 0), (0, 0)))

    def query_block(j):
        start = j * Q_BLOCK
        t = start + jnp.arange(Q_BLOCK)
        qb = lax.dynamic_slice_in_dim(q, start, Q_BLOCK, axis=1).reshape(b, Q_BLOCK, G, HG, D)
        gb = lax.dynamic_slice_in_dim(gates, start, Q_BLOCK, axis=1).reshape(b, Q_BLOCK, G, HG, 3)

        s_c = jnp.einsum('bqghd,bkgd->bghqk', qb, k_cmp)
        p_c = masked_softmax(s_c, cmp_end[None, :] <= t[:, None])
        o_c = jnp.einsum('bghqk,bkgd->bqghd', p_c.astype(v_cmp.dtype), v_cmp)

        imp = selection_importance(jnp.sum(p_c, axis=2), n_sel)
        cur = t // SEL_BLOCK
        forced = (blk[None, :] == 0) | (blk[None, :] == cur[:, None]) | (blk[None, :] == cur[:, None] - 1)
        valid = blk[None, :] * SEL_BLOCK <= t[:, None]
        imp = jnp.where(forced, jnp.inf, jnp.where(valid, imp, -jnp.inf))
        _, idx = lax.top_k(imp, top_n)
        k_g = k_sel[bi, gi, idx]
        v_g = v_sel[bi, gi, idx]
        s_s = jnp.einsum('bqghd,bgqnkd->bghqnk', qb, k_g).reshape(b, G, HG, Q_BLOCK, top_n * SEL_BLOCK)
        tok = (idx[..., None] * SEL_BLOCK + jnp.arange(SEL_BLOCK)).reshape(b, G, Q_BLOCK, top_n * SEL_BLOCK)
        p_s = masked_softmax(s_s, tok[:, :, None] <= t[:, None])
        p_s = p_s.reshape(b, G, HG, Q_BLOCK, top_n, SEL_BLOCK)
        o_s = jnp.einsum('bghqnk,bgqnkd->bqghd', p_s.astype(v_g.dtype), v_g)

        kw = lax.dynamic_slice_in_dim(k_win, start, Q_BLOCK + WINDOW, axis=1)
        vw = lax.dynamic_slice_in_dim(v_win, start, Q_BLOCK + WINDOW, axis=1)
        kpos = start - WINDOW + jnp.arange(Q_BLOCK + WINDOW)
        mask_w = (kpos[None, :] <= t[:, None]) & (kpos[None, :] > t[:, None] - WINDOW) & (kpos[None, :] >= 0)
        s_w = jnp.einsum('bqghd,bkgd->bghqk', qb, kw)
        p_w = masked_softmax(s_w, mask_w)
        o_w = jnp.einsum('bghqk,bkgd->bqghd', p_w.astype(vw.dtype), vw)

        o = gb[..., 0:1] * o_c + gb[..., 1:2] * o_s + gb[..., 2:3] * o_w
        return o.reshape(b, Q_BLOCK, H * D).astype(h.dtype)

    out = lax.map(query_block, jnp.arange(s // Q_BLOCK))
    out = out.transpose(1, 0, 2, 3).reshape(b, s, H * D)
    return out @ w_out


def hgrn2_mixer(h, w_in, w_out, norm_gain, lower_bound):
    b, s, _ = h.shape
    H, DK, DV, C = HGRN_HEADS, HGRN_DK, HGRN_DV, HGRN_CHUNK
    q, f, i, g = jnp.split(h @ w_in, [H * DK, 2 * H * DK, 2 * H * DK + H * DV], axis=-1)
    q = jax.nn.silu(q.astype(jnp.float32))
    lb = lower_bound.astype(jnp.float32)
    log_f = jnp.logaddexp(jnp.log(lb), jnp.log1p(-lb) + jax.nn.log_sigmoid(f.astype(jnp.float32)))
    k = -jnp.expm1(log_f)

    def to_chunks(t, d):
        return t.reshape(b, s // C, C, H, d).transpose(1, 0, 3, 2, 4)

    xs = (to_chunks(q, DK), to_chunks(k, DK), to_chunks(i.astype(jnp.float32), DV), to_chunks(log_f, DK))
    causal = jnp.tril(jnp.ones((C, C), dtype=bool))[None, None, :, :, None]

    def chunk_step(state, inp):
        q_c, k_c, v_c, lf_c = inp
        cum = jnp.cumsum(lf_c, axis=2)
        diff = cum[:, :, :, None, :] - cum[:, :, None, :, :]
        decay = jnp.exp(jnp.where(causal, diff, -jnp.inf))
        att = jnp.einsum('bhtd,bhsd,bhtsd->bhts', q_c, k_c, decay)
        o = jnp.einsum('bhts,bhse->bhte', att, v_c) + jnp.einsum('bhtd,bhde->bhte', q_c * jnp.exp(cum), state)
        last = cum[:, :, -1]
        state = jnp.exp(last)[..., None] * state + jnp.einsum(
            'bhsd,bhse->bhde', k_c * jnp.exp(last[:, :, None, :] - cum), v_c)
        return state, o

    state0 = jnp.zeros((b, H, DK, DV), jnp.float32)
    _, o = lax.scan(chunk_step, state0, xs)
    o = o.transpose(1, 0, 3, 2, 4).reshape(b, s, H, DV)
    o = rms_norm(o, norm_gain) * jax.nn.silu(g.astype(jnp.float32)).reshape(b, s, H, DV)
    return o.reshape(b, s, H * DV).astype(h.dtype) @ w_out


def setup_inputs(seed: int = 0) -> dict:
    key = jax.random.key(seed)
    ks = jax.random.split(key, 16)
    n_nsa = (DEPTH + 1) // 2
    n_hgrn = DEPTH // 2
    f32 = jnp.float32

    def w(k, shape, fan_in):
        return jax.random.normal(k, shape, f32) * (fan_in ** -0.5)

    return {
        "x": jax.random.normal(ks[0], (BATCH, SEQ, D_MODEL), f32),
        "p": jax.random.normal(ks[1], (DEPTH, BATCH, SEQ, PLE_DIM), f32),
        "norm_gains": 1.0 + 0.05 * jax.random.normal(ks[2], (DEPTH, 8, D_MODEL), f32),
        "ffn_w_in": w(ks[3], (DEPTH, 2, D_MODEL, 2 * D_FF), D_MODEL),
        "ffn_w_out": w(ks[4], (DEPTH, 2, D_FF, D_MODEL), D_FF),
        "ple_w_in": w(ks[5], (DEPTH, PLE_DIM, D_MODEL), PLE_DIM),
        "ple_w_gate": w(ks[6], (DEPTH, D_MODEL, D_MODEL), D_MODEL),
        "nsa_w_in": w(ks[7], (n_nsa, D_MODEL, NSA_IN_COLS), D_MODEL),
        "nsa_w_out": w(ks[8], (n_nsa, NSA_Q_COLS, D_MODEL), NSA_Q_COLS),
        "nsa_cmp_pos": 0.5 * jax.random.normal(ks[9], (n_nsa, 2, CMP_BLOCK, NSA_HEAD_DIM), f32),
        "nsa_cmp_w1": w(ks[10], (n_nsa, 2, CMP_BLOCK * NSA_HEAD_DIM, NSA_HEAD_DIM), CMP_BLOCK * NSA_HEAD_DIM),
        "nsa_cmp_w2": w(ks[11], (n_nsa, 2, NSA_HEAD_DIM, NSA_HEAD_DIM), NSA_HEAD_DIM),
        "hgrn_w_in": w(ks[12], (n_hgrn, D_MODEL, HGRN_IN_COLS), D_MODEL),
        "hgrn_w_out": w(ks[13], (n_hgrn, HGRN_HEADS * HGRN_DV, D_MODEL), HGRN_HEADS * HGRN_DV),
        "hgrn_norm": 1.0 + 0.05 * jax.random.normal(ks[14], (n_hgrn, HGRN_DV), f32),
        "hgrn_lb_logits": jax.random.normal(ks[15], (DEPTH, HGRN_HEADS * HGRN_DK), f32),
    }


def reference(x, p, norm_gains, ffn_w_in, ffn_w_out, ple_w_in, ple_w_gate,
              nsa_w_in, nsa_w_out, nsa_cmp_pos, nsa_cmp_w1, nsa_cmp_w2,
              hgrn_w_in, hgrn_w_out, hgrn_norm, hgrn_lb_logits):
    lb_sm = jax.nn.softmax(hgrn_lb_logits.astype(jnp.float32), axis=0)
    lower_bounds = jnp.cumsum(lb_sm, axis=0) - lb_sm[0]
    for layer in range(DEPTH):
        ng = norm_gains[layer]
        x = x + 0.5 * rms_norm(swiglu(rms_norm(x, ng[0]), ffn_w_in[layer, 0], ffn_w_out[layer, 0]), ng[1])
        hn = rms_norm(x, ng[2])
        j = layer // N_MIXERS
        if layer % N_MIXERS == 0:
            y = nsa_mixer(hn, nsa_w_in[j], nsa_w_out[j], nsa_cmp_pos[j], nsa_cmp_w1[j], nsa_cmp_w2[j])
        else:
            y = hgrn2_mixer(hn, hgrn_w_in[j], hgrn_w_out[j], hgrn_norm[j], lower_bounds[layer])
        x = x + rms_norm(y, ng[3])
        x = x + 0.5 * rms_norm(swiglu(rms_norm(x, ng[4]), ffn_w_in[layer, 1], ffn_w_out[layer, 1]), ng[5])
        gate = jax.nn.sigmoid(rms_norm(x, ng[6]) @ ple_w_gate[layer])
        x = x + rms_norm((p[layer] @ ple_w_in[layer]) * gate, ng[7])
    return x
```

```cpp
#include <hip/hip_runtime.h>
#include <cstdio>
#include <cstdint>
#include <cmath>
namespace pg8 {
#define PG8_LAS __attribute__((address_space(3)))
typedef unsigned short bf16_t;
typedef _Float16 bf16x8 __attribute__((ext_vector_type(8)));
typedef float f32x4 __attribute__((ext_vector_type(4)));
typedef unsigned u32x4 __attribute__((ext_vector_type(4)));
constexpr int BM = 256, BK = 64, HALF = 128, HTB = HALF * BK * 2  , STAGE_BYTES = 8 * HTB, NXCD = 8, WGM = 8;

__host__ __device__ __forceinline__ int lds_byte(int r, int c) { const int st = (r >> 4) * 2 + (c >> 5), rr = r & 15, cc = c & 31, ob = rr * 64 + cc * 2; return st * 1024 + (ob ^ (((ob >> 9) & 1) << 5)); }
__host__ __device__ __forceinline__ void stage_rc(int b, int& R, int& C) { const int st = b / 1024, sb = b % 1024, swz = sb ^ (((sb >> 9) & 1) << 5); R = (st >> 1) * 16 + swz / 64; C = (st & 1) * 32 + (swz % 64) / 2; }
__host__ __device__ __forceinline__ int perm32(int rho) { const int n = rho >> 4, i = rho & 15; return 8 * (i >> 2) + 4 * n + (i & 3); }

struct Unit { int pm, pn; };
struct Gemm { const bf16_t* A; const bf16_t* Bt; int M, N, K; int tid; };

struct StaticOrder {
    int nM, nN, nwg, G, c;
    __host__ __device__ void init(int M, int N, int G_, int c_) { nM = M / BM; nN = N / BM; nwg = nM * nN; G = G_; c = c_; }
    __host__ __device__ bool next(int i, Unit& u) const {
        const long L = (long)i * G + c; if (L >= nwg) return false;
        int wgid = (int)L; { const int q = nwg / NXCD, r = nwg % NXCD, xcd = wgid % NXCD, off = wgid / NXCD; wgid = (xcd < r ? xcd * (q + 1) : r * (q + 1) + (xcd - r) * q) + off; }
        const int nig = WGM * nN, gid = wgid / nig, fm = gid * WGM, gsz = (nM - fm) < WGM ? (nM - fm) : WGM;
        u.pm = fm + ((wgid % nig) % gsz); u.pn = (wgid % nig) / gsz; return true;
    }
    __device__ __forceinline__ void a_ready(const Unit&) const {}
    __device__ __forceinline__ void done(const Unit&) const {}
};

template <class Epi, class Sched, bool ALIGN_EPI = false, bool SP2 = false>
__device__ __forceinline__ void gemm_phase(PG8_LAS unsigned char* lds, const Gemm g, const Sched& S, const Epi& E) {
    int tid_l = g.tid; asm volatile("" : "+v"(tid_l));
    const int tid = tid_l, wid = __builtin_amdgcn_readfirstlane(tid >> 6), lane = tid & 63, wr = wid >> 2, wc = wid & 3, fr = lane & 15, fq = lane >> 4;
    const int K = g.K, nt = K / BK;
    unsigned voffA[2], voffB[2];
#pragma unroll
    for (int i = 0; i < 2; ++i) { int R, C; stage_rc(tid * 16 + i * 8192, R, C); const int Rb = Epi::PERM ? ((R & ~31) + perm32(R & 31)) : R;
        voffA[i] = (unsigned)(R * K + C) * 2u; voffB[i] = (unsigned)(Rb * K + C) * 2u; }
    const size_t kstep = (size_t)(BK * 2);
    const size_t hstep = (size_t)HALF * K * 2;
    const size_t tstep = 2 * hstep;
    const unsigned ldsw = (unsigned)wid * 1024u;
    const int aoff = lds_byte(wr * 64 + fr, fq * 8), boff = lds_byte(wc * 32 + fr, fq * 8);
#define PG8_SA(b, h) (((b) * 2 + (h)) * HTB)
#define PG8_SB(b, h) ((4 + (b) * 2 + (h)) * HTB)
#define PG8_STAGE(bufoff, gbase, voff) do { _Pragma("unroll") for (int _i = 0; _i < 2; ++_i) \
        __builtin_amdgcn_global_load_lds((const unsigned*)((const char*)(gbase) + (voff)[_i]), (PG8_LAS unsigned*)(lds + (bufoff) + ldsw + _i * 8192), 16, 0, 0); } while (0)
#define PG8_LDA(dst, b, h) do { _Pragma("unroll") for (int m = 0; m < 4; ++m) _Pragma("unroll") for (int k = 0; k < 2; ++k) dst[m][k] = *(const PG8_LAS bf16x8*)(lds + PG8_SA(b, h) + aoff + m * 2048 + k * 1024); } while (0)
#define PG8_LDB(dst, b, h) do { _Pragma("unroll") for (int n = 0; n < 2; ++n) _Pragma("unroll") for (int k = 0; k < 2; ++k) dst[n][k] = *(const PG8_LAS bf16x8*)(lds + PG8_SB(b, h) + boff + n * 2048 + k * 1024); } while (0)
#define PG8_MMA(ai, bj, At, Bt) do { __builtin_amdgcn_s_setprio(1); _Pragma("unroll") for (int m = 0; m < 4; ++m) _Pragma("unroll") for (int n = 0; n < 2; ++n) _Pragma("unroll") for (int k = 0; k < 2; ++k) \
        acc[ai][bj][m][n] = __builtin_amdgcn_mfma_f32_16x16x32_f16(Bt[n][k], At[m][k], acc[ai][bj][m][n], 0, 0, 0); __builtin_amdgcn_s_setprio(0); } while (0)
#define PG8_WAIT_V(n) asm volatile("s_waitcnt vmcnt(" #n ")" ::: "memory")
#define PG8_WAIT_L(n) asm volatile("s_waitcnt lgkmcnt(" #n ")" ::: "memory")
#define PG8_BAR __builtin_amdgcn_s_barrier()
#define PG8_SCHED __builtin_amdgcn_sched_barrier(0)
    Unit cur, nxt; int ui = 0;
    if (!S.next(0, cur)) return;
    f32x4 acc[2][2][4][2];
#pragma unroll
    for (int a = 0; a < 2; ++a)
#pragma unroll
        for (int b = 0; b < 2; ++b)
#pragma unroll
            for (int m = 0; m < 4; ++m)
#pragma unroll
                for (int n = 0; n < 2; ++n) acc[a][b][m][n] = (f32x4){0.f, 0.f, 0.f, 0.f};
    bf16x8 At[4][2], B0[2][2], B1[2][2];
    const char* cA = (const char*)g.A + (size_t)cur.pm * tstep; const char* cB = (const char*)g.Bt + (size_t)cur.pn * tstep;
    S.a_ready(cur);
    if constexpr (SP2) {
        PG8_STAGE(PG8_SB(0, 0), cB, voffB); PG8_STAGE(PG8_SB(0, 1), cB + hstep, voffB); PG8_STAGE(PG8_SA(0, 0), cA, voffA); PG8_STAGE(PG8_SA(0, 1), cA + hstep, voffA);
        if (wr == 1) PG8_BAR;
        PG8_WAIT_V(2); PG8_BAR;
        PG8_STAGE(PG8_SB(1, 0), cB + kstep, voffB); PG8_STAGE(PG8_SA(1, 0), cA + kstep, voffA); PG8_STAGE(PG8_SB(1, 1), cB + hstep + kstep, voffB);
        PG8_WAIT_V(6); PG8_BAR;
    } else {
        PG8_STAGE(PG8_SB(0, 0), cB, voffB); PG8_STAGE(PG8_SA(0, 0), cA, voffA); PG8_STAGE(PG8_SB(0, 1), cB + hstep, voffB); PG8_STAGE(PG8_SA(0, 1), cA + hstep, voffA);
        if (wr == 1) PG8_BAR;
        PG8_WAIT_V(4); PG8_BAR;
        PG8_STAGE(PG8_SB(1, 0), cB + kstep, voffB); PG8_STAGE(PG8_SA(1, 0), cA + kstep, voffA); PG8_STAGE(PG8_SB(1, 1), cB + hstep + kstep, voffB);
        PG8_WAIT_V(6); PG8_BAR;
    }
    for (;;) {
        const bool has_next = S.next(ui + 1, nxt);
        const char* nA = has_next ? (const char*)g.A + (size_t)nxt.pm * tstep : cA; const char* nB = has_next ? (const char*)g.Bt + (size_t)nxt.pn * tstep : cB;
        for (int t = 0; t < nt; t += 2) {
            const bool last = (t == nt - 2);
            const char* a1 = cA + (size_t)(t + 1) * kstep;
            const char* a2 = last ? nA : cA + (size_t)(t + 2) * kstep; const char* b2 = last ? nB : cB + (size_t)(t + 2) * kstep;
            const char* a3 = a2 + kstep; const char* b3 = b2 + kstep;
            if (last && has_next) S.a_ready(nxt);
            if constexpr (SP2) {
            PG8_LDB(B0, 0, 0); PG8_LDB(B1, 0, 1); PG8_SCHED; PG8_LDA(At, 0, 0); PG8_STAGE(PG8_SA(1, 1), a1 + hstep, voffA);
            PG8_WAIT_V(8); PG8_WAIT_L(0); PG8_BAR; PG8_MMA(0, 0, At, B0); PG8_MMA(0, 1, At, B1); PG8_BAR; PG8_SCHED;
            PG8_LDA(At, 0, 1); PG8_STAGE(PG8_SB(0, 0), b2, voffB); PG8_STAGE(PG8_SB(0, 1), b2 + hstep, voffB); PG8_STAGE(PG8_SA(0, 0), a2, voffA);
            PG8_WAIT_V(8); PG8_WAIT_L(0); PG8_BAR; PG8_MMA(1, 0, At, B0); PG8_MMA(1, 1, At, B1); PG8_BAR; PG8_SCHED;
            PG8_LDB(B0, 1, 0); PG8_LDB(B1, 1, 1); PG8_SCHED; PG8_LDA(At, 1, 0); PG8_STAGE(PG8_SA(0, 1), a2 + hstep, voffA);
            PG8_WAIT_V(8); PG8_WAIT_L(0); PG8_BAR; PG8_MMA(0, 0, At, B0); PG8_MMA(0, 1, At, B1); PG8_BAR; PG8_SCHED;
            PG8_LDA(At, 1, 1); PG8_STAGE(PG8_SB(1, 0), b3, voffB); PG8_STAGE(PG8_SB(1, 1), b3 + hstep, voffB); PG8_STAGE(PG8_SA(1, 0), a3, voffA);
            PG8_WAIT_V(8); PG8_WAIT_L(0); PG8_BAR; PG8_MMA(1, 0, At, B0); PG8_MMA(1, 1, At, B1); PG8_BAR; PG8_SCHED;
            } else {
            PG8_LDB(B0, 0, 0); PG8_SCHED; PG8_LDA(At, 0, 0); PG8_STAGE(PG8_SA(1, 1), a1 + hstep, voffA);
            PG8_WAIT_L(8); PG8_BAR; PG8_WAIT_L(0); PG8_MMA(0, 0, At, B0); PG8_BAR; PG8_SCHED;
            PG8_LDB(B1, 0, 1); PG8_STAGE(PG8_SB(0, 0), b2, voffB);
            PG8_BAR; PG8_WAIT_L(0); PG8_MMA(0, 1, At, B1); PG8_BAR;
            PG8_LDA(At, 0, 1); PG8_STAGE(PG8_SA(0, 0), a2, voffA);
            PG8_BAR; PG8_WAIT_L(0); PG8_MMA(1, 0, At, B0); PG8_BAR; PG8_SCHED;
            PG8_STAGE(PG8_SB(0, 1), b2 + hstep, voffB);
            PG8_WAIT_V(6); PG8_BAR; PG8_MMA(1, 1, At, B1); PG8_BAR;
            PG8_LDB(B0, 1, 0); PG8_SCHED; PG8_LDA(At, 1, 0); PG8_STAGE(PG8_SA(0, 1), a2 + hstep, voffA);
            PG8_WAIT_L(8); PG8_BAR; PG8_WAIT_L(0); PG8_MMA(0, 0, At, B0); PG8_BAR; PG8_SCHED;
            PG8_LDB(B1, 1, 1); PG8_STAGE(PG8_SB(1, 0), b3, voffB);
            PG8_BAR; PG8_WAIT_L(0); PG8_MMA(0, 1, At, B1); PG8_BAR;
            PG8_LDA(At, 1, 1); PG8_STAGE(PG8_SA(1, 0), a3, voffA);
            PG8_BAR; PG8_WAIT_L(0); PG8_MMA(1, 0, At, B0); PG8_BAR; PG8_SCHED;
            PG8_STAGE(PG8_SB(1, 1), b3 + hstep, voffB);
            PG8_WAIT_V(6); PG8_BAR; PG8_MMA(1, 1, At, B1); PG8_BAR;
            }
        }
        if constexpr (ALIGN_EPI) { if (wr == 0) PG8_BAR; }
        if constexpr (!Epi::AFTER_DRAIN) { E(acc, cur, wr, wc, fr, fq); S.done(cur); }
        if (!has_next) break;
#pragma unroll
        for (int a = 0; a < 2; ++a)
#pragma unroll
            for (int b = 0; b < 2; ++b)
#pragma unroll
                for (int m = 0; m < 4; ++m)
#pragma unroll
                    for (int n = 0; n < 2; ++n) acc[a][b][m][n] = (f32x4){0.f, 0.f, 0.f, 0.f};
        cur = nxt; cA = nA; cB = nB; ++ui;
        if constexpr (ALIGN_EPI) { if (wr == 1) PG8_BAR; }
    }
    PG8_WAIT_V(0);
    if constexpr (!ALIGN_EPI) { if (wr == 0) PG8_BAR; }
    PG8_BAR;
    if constexpr (Epi::AFTER_DRAIN) { E.fused(acc, cur, wr, wc, fr, fq, lds, wid, lane); S.done(cur); }
#undef PG8_SA
#undef PG8_SB
#undef PG8_STAGE
#undef PG8_LDA
#undef PG8_LDB
#undef PG8_MMA
#undef PG8_WAIT_V
#undef PG8_WAIT_L
#undef PG8_BAR
#undef PG8_SCHED
}
}

#define GAS __attribute__((address_space(1)))
#define LAS __attribute__((address_space(3)))
#define XB_TMO      128
#define XB_XCNT(j)  (256  + 64 * (j))
#define XB_XSUB(j)  (1280 + 64 * (j))
#define XB_XGEN(j)  (2304 + 64 * (j))
#define XB_TOP      3328
#define XB_TOPGEN   3392
#define XCD_BAR_WORDS 3456
#define XB_SPIN_CAP (1u << 18)

__device__ __forceinline__ unsigned xb_ld(unsigned* p)              { return __hip_atomic_load(p, __ATOMIC_RELAXED, __HIP_MEMORY_SCOPE_AGENT); }
__device__ __forceinline__ unsigned xb_add(unsigned* p, unsigned v) { return __hip_atomic_fetch_add(p, v, __ATOMIC_RELAXED, __HIP_MEMORY_SCOPE_AGENT); }
__device__ __forceinline__ unsigned xb_xcc_id() { return (unsigned)__builtin_amdgcn_s_getreg((3 << 11) | 20) & 0xFu; }
#define XB_SPIN(cond, bar) do { unsigned _sp = 0; while (cond) { __builtin_amdgcn_s_sleep(1); \
    if ((++_sp & 255u) == 0u) { if (xb_ld(&(bar)[XB_TMO])) break; if (_sp > XB_SPIN_CAP) { atomicAdd(&(bar)[XB_TMO], 1u); break; } } } } while (0)

struct XcdBarrier {
    unsigned* bar; unsigned x;
    volatile LAS unsigned* st;
};

__device__ __forceinline__ XcdBarrier xcd_barrier_post(unsigned* bar, volatile LAS unsigned* st) {
    XcdBarrier b; b.bar = bar; b.x = xb_xcc_id(); b.st = st;
    if (threadIdx.x == 0) (void)xb_add(&bar[XB_XCNT(b.x)], 1u);
    return b;
}
__device__ __forceinline__ void xcd_barrier_complete(unsigned* bar, unsigned x, unsigned& nloc, unsigned& nx) {
    const unsigned G = gridDim.x * gridDim.y * gridDim.z;
    unsigned sum, cnt, mine, sp = 0u;
    for (;;) {
        sum = 0u; cnt = 0u; mine = 0u;
#pragma unroll
        for (unsigned j = 0; j < 16; ++j) { const unsigned c = xb_ld(&bar[XB_XCNT(j)]); sum += c; cnt += (c > 0u) ? 1u : 0u; mine = (j == x) ? c : mine; }
        if (sum == G) break;
        __builtin_amdgcn_s_sleep(1);
        if ((++sp & 255u) == 0u) { if (xb_ld(&bar[XB_TMO])) break; if (sp > XB_SPIN_CAP) { atomicAdd(&bar[XB_TMO], 1u); break; } }
    }
    nloc = mine > 0u ? mine : 1u; nx = cnt > 0u ? cnt : 1u;
}

__device__ __forceinline__ void xcd_barrier(const XcdBarrier& b) {
    asm volatile("s_waitcnt vmcnt(0)" ::: "memory");
    __syncthreads();
    if (threadIdx.x == 0) {
        unsigned* bar = b.bar;
        __builtin_amdgcn_s_waitcnt(0);
        unsigned nloc = b.st[0], nx = b.st[1];
        if (nloc == 0u) { xcd_barrier_complete(bar, b.x, nloc, nx); b.st[0] = nloc; b.st[1] = nx; }
        const unsigned old = xb_add(&bar[XB_XSUB(b.x)], 1u);
        const unsigned gen = old / nloc;
        if (old + 1u == (gen + 1u) * nloc) {
            __builtin_amdgcn_fence(__ATOMIC_RELEASE, "agent");
            asm volatile("s_waitcnt vmcnt(0)" ::: "memory");
            const unsigned og = xb_add(&bar[XB_TOP], 1u);
            const unsigned tg = og / nx;
            if (og + 1u == (tg + 1u) * nx) xb_add(&bar[XB_TOPGEN], 1u);
            else XB_SPIN(xb_ld(&bar[XB_TOPGEN]) == tg, bar);
            __builtin_amdgcn_fence(__ATOMIC_ACQUIRE, "agent");
            xb_add(&bar[XB_XGEN(b.x)], 1u);
            asm volatile("s_waitcnt vmcnt(0)" ::: "memory");
        } else {
            XB_SPIN(xb_ld(&bar[XB_XGEN(b.x)]) == gen, bar);
            __builtin_amdgcn_fence(__ATOMIC_ACQUIRE, "agent");
            asm volatile("s_waitcnt vmcnt(0)" ::: "memory");
        }
    }
    __syncthreads();
}


constexpr int BATCH = 2, SEQ = 16384, DM = 1024, T = BATCH * SEQ, DFF = 2816, PLED = 256, DEPTH = 2;
constexpr int NH = 16, NG = 4, HD = 64, NSA_IN = 2608, NSA_NP = 2816;
constexpr int NCMP = 1023, NCMP_P = 1024;
constexpr int HG_H = 8, HG_D = 128;
constexpr float NORM_EPS = 1e-6f;
constexpr float LOG2E = 1.4426950408889634f;
constexpr int NWAVES = 8, NTHREADS = 512;

constexpr size_t MiB = 1u << 20;
constexpr size_t WS_CTL = 0, CTL_ZERO_BYTES = 1 * MiB;
constexpr size_t WS_ROPE_C = 1 * MiB, WS_ROPE_S = 3 * MiB;
constexpr size_t WS_MISC = 5 * MiB;
constexpr size_t WS_W = 6 * MiB;
constexpr size_t W_FI = 0;
constexpr size_t W_FI_SZ = (size_t)2 * DFF * DM * 2;
constexpr size_t W_FO = W_FI + 4 * W_FI_SZ;
constexpr size_t W_FO_SZ = (size_t)DM * DFF * 2;
constexpr size_t W_PI = W_FO + 4 * W_FO_SZ;
constexpr size_t W_PI_SZ = (size_t)DM * PLED * 2;
constexpr size_t W_PG = W_PI + 2 * W_PI_SZ;
constexpr size_t W_SQ_SZ = (size_t)DM * DM * 2;
constexpr size_t W_NI = W_PG + 2 * W_SQ_SZ;
constexpr size_t W_NI_SZ = (size_t)NSA_NP * DM * 2;
constexpr size_t W_NO = W_NI + W_NI_SZ;
constexpr size_t W_HI = W_NO + W_SQ_SZ;
constexpr size_t W_HI_SZ = (size_t)4096 * DM * 2;
constexpr size_t W_HO = W_HI + W_HI_SZ;
constexpr size_t W_C1 = W_HO + W_SQ_SZ;
constexpr size_t W_C1_SZ = (size_t)64 * 2048 * 2;
constexpr size_t W_C2 = W_C1 + 2 * W_C1_SZ;
constexpr size_t W_C2_SZ = (size_t)64 * 64 * 2;
constexpr size_t W_END = W_C2 + 2 * W_C2_SZ;
static_assert(W_END <= 96 * MiB, "weights region");
constexpr size_t WS_PH = 102 * MiB;
constexpr size_t WS_H = 134 * MiB;
constexpr size_t WS_Y = 198 * MiB;
constexpr size_t WS_X = 262 * MiB;
constexpr size_t X_ACT = 0;
constexpr size_t X_Q = 0, X_KC = 64 * MiB, X_VC = 80 * MiB, X_KS = 96 * MiB, X_VS = 112 * MiB, X_KW = 128 * MiB, X_VW = 144 * MiB;
constexpr size_t X_GATES = 160 * MiB, X_KCMP = 168 * MiB, X_VCMP = 169 * MiB, X_OSCR = 170 * MiB;
constexpr size_t X_QH = 0, X_LF = 64 * MiB, X_VH = 128 * MiB, X_ST = 192 * MiB, X_DT = 208 * MiB;
constexpr size_t X_PE = 0;
constexpr size_t WS_END = 471 * MiB;
constexpr int CW_BAR = 4096, CW_SS = 32768;

constexpr int RING_BYTES = 131072;
constexpr int LDSCTL_OFF = RING_BYTES;
constexpr int LDS_BYTES = 147456;

#ifdef PROF
#define PROF_T0 (LDSCTL_OFF + 64)
#define PROF_ACC (LDSCTL_OFF + 72)
#define PROF_BEGIN(id) do { if ((id) == PROF && threadIdx.x == 0) *(LAS unsigned long long*)(lds + PROF_T0) = __builtin_amdgcn_s_memrealtime(); } while (0)
#define PROF_END(id) do { if ((id) == PROF && threadIdx.x == 0) { *(LAS unsigned long long*)(lds + PROF_ACC) += __builtin_amdgcn_s_memrealtime() - *(LAS unsigned long long*)(lds + PROF_T0); } } while (0)
#else
#define PROF_BEGIN(id) do { } while (0)
#define PROF_END(id) do { } while (0)
#endif

typedef _Float16 h16;
typedef _Float16 h16x8 __attribute__((ext_vector_type(8)));
typedef _Float16 h16x4 __attribute__((ext_vector_type(4)));
typedef _Float16 h16x2 __attribute__((ext_vector_type(2)));
typedef __bf16 b16x8 __attribute__((ext_vector_type(8)));
typedef __bf16 b16x4 __attribute__((ext_vector_type(4)));
typedef float f32x4 __attribute__((ext_vector_type(4)));
typedef float f32x2 __attribute__((ext_vector_type(2)));
typedef unsigned u32x4 __attribute__((ext_vector_type(4)));
typedef unsigned u32x2 __attribute__((ext_vector_type(2)));
typedef short s16x4 __attribute__((ext_vector_type(4)));
typedef short s16x8 __attribute__((ext_vector_type(8)));

#define DI __device__ __forceinline__
#define LDS_WAIT() asm volatile("s_waitcnt lgkmcnt(0)" ::: "memory")

DI float wave_sum(float v) {
#pragma unroll
    for (int o = 1; o < 64; o <<= 1) v += __shfl_xor(v, o);
    return v;
}
DI float sigmoidf_(float x) { return 1.0f / (1.0f + __expf(-x)); }
DI float siluf_(float x) { return x / (1.0f + __expf(-x)); }
DI unsigned pkh(float a, float b) { h16x2 v = {(h16)a, (h16)b}; return __builtin_bit_cast(unsigned, v); }
DI u32x4 pkh8(f32x4 a, f32x4 b) { u32x4 w; w.x = pkh(a[0], a[1]); w.y = pkh(a[2], a[3]); w.z = pkh(b[0], b[1]); w.w = pkh(b[2], b[3]); return w; }
DI unsigned pkb(float a, float b) { typedef __bf16 b2 __attribute__((ext_vector_type(2))); f32x2 f = {a, b}; b2 v = __builtin_convertvector(f, b2); return __builtin_bit_cast(unsigned, v); }

struct Ptrs {
    const float *x, *p, *ng, *ffn_in, *ffn_out, *ple_in, *ple_gate, *nsa_in, *nsa_out, *cmp_pos, *cmp_w1, *cmp_w2, *hg_in, *hg_out, *hg_norm, *hg_lb;
    float* out; unsigned char* ws;
};

DI void transpose_item(const float* W, int ldw, int K, h16* WT, int dstrow0, int srccol0, int nvalid, int k0, LAS float* scr, int lane) {
    const int nn = lane & 31;
#pragma unroll 8
    for (int i = 0; i < 32; ++i) { const int kk = 2 * i + (lane >> 5); scr[kk * 33 + nn] = (nn < nvalid) ? W[(size_t)(k0 + kk) * ldw + srccol0 + nn] : 0.f; }
    LDS_WAIT(); asm volatile("" ::: "memory");
    const int c = lane & 7;
#pragma unroll
    for (int j = 0; j < 4; ++j) { const int n = (lane >> 3) + 8 * j; const LAS float* s = scr + (8 * c) * 33 + n;
        u32x4 o; o.x = pkh(s[0 * 33], s[1 * 33]); o.y = pkh(s[2 * 33], s[3 * 33]); o.z = pkh(s[4 * 33], s[5 * 33]); o.w = pkh(s[6 * 33], s[7 * 33]);
        *(GAS u32x4*)(WT + (size_t)(dstrow0 + n) * K + k0 + 8 * c) = o; }
    LDS_WAIT(); asm volatile("" ::: "memory");
}
template <int MAP> DI bool conv_matrix(int& it, const float* W, int ldw, int K, int NR, h16* WT, LAS float* scr, int lane) {
    const int nrb = NR / 32, nitems = (K / 64) * nrb;
    if (it >= nitems) { it -= nitems; return false; }
    const int kb = it / nrb, rb = it % nrb, c0 = 32 * rb;
    int src = c0, nvalid = 32;
    if (MAP == 1) { const int pn = c0 >> 8, bj = (c0 >> 7) & 1, j0 = c0 & 127; src = bj * DFF + 128 * pn + j0; }
    if (MAP == 2) { const int pn = c0 >> 8, bj = (c0 >> 7) & 1, hl = (c0 & 127) >> 5;
        if (pn < 4) src = (4 * pn + hl) * 64 + 32 * bj;
        else if (pn < 10) src = 1024 + (pn - 4) * 256 + hl * 64 + 32 * bj;
        else { const int jj = c0 & 255; src = 2560 + jj; nvalid = 48 - jj; nvalid = nvalid < 0 ? 0 : (nvalid > 32 ? 32 : nvalid); if (nvalid == 0) src = 0; } }
    transpose_item(W, ldw, K, WT, c0, src, nvalid, 64 * kb, scr, lane);
    return true;
}
DI void rms_row_to_h16(const float* xrow, const float* gain, h16* orow, float* xcopy, int lane) {
    const GAS f32x4* xr = (const GAS f32x4*)xrow; const GAS f32x4* gr = (const GAS f32x4*)gain;
    f32x4 v[4]; float s = 0.f;
#pragma unroll
    for (int j = 0; j < 2; ++j) { v[2 * j] = xr[2 * lane + 128 * j]; v[2 * j + 1] = xr[2 * lane + 1 + 128 * j]; }
#pragma unroll
    for (int j = 0; j < 4; ++j) s += (v[j].x * v[j].x + v[j].y * v[j].y) + (v[j].z * v[j].z + v[j].w * v[j].w);
    const float r = rsqrtf(wave_sum(s) * (1.f / DM) + NORM_EPS);
#pragma unroll
    for (int j = 0; j < 2; ++j) {
        if (xcopy) { ((GAS f32x4*)xcopy)[2 * lane + 128 * j] = v[2 * j]; ((GAS f32x4*)xcopy)[2 * lane + 1 + 128 * j] = v[2 * j + 1]; }
        const f32x4 g0 = gr[2 * lane + 128 * j], g1 = gr[2 * lane + 1 + 128 * j];
        *(GAS u32x4*)(orow + 8 * lane + 512 * j) = pkh8(v[2 * j] * r * g0, v[2 * j + 1] * r * g1); }
}
DI void p0_prologue(const Ptrs& P, LAS unsigned char* lds, int vcu, int G, int wave, int lane) {
    LAS float* scr = (LAS float*)(lds + wave * 16384);
    const int gw = vcu * NWAVES + wave, NGW = G * NWAVES;
    unsigned char* wb = P.ws + WS_W;
    constexpr int I_FI = 16 * 176, I_FO = 44 * 32, I_PI = 4 * 32, I_SQ = 16 * 32, I_NI = 16 * 88, I_HI = 16 * 128, I_C1 = 32 * 2, I_C2 = 2;
    constexpr int NITEMS = 4 * I_FI + 4 * I_FO + 2 * I_PI + 2 * I_SQ + I_NI + I_SQ + I_HI + I_SQ + 2 * I_C1 + 2 * I_C2;
    for (int it0 = gw; it0 < NITEMS; it0 += NGW) {
        int it = it0; bool done = false;
        for (int m = 0; m < 4 && !done; ++m) done = conv_matrix<1>(it, P.ffn_in + (size_t)m * DM * 2 * DFF, 2 * DFF, DM, 2 * DFF, (h16*)(wb + W_FI + m * W_FI_SZ), scr, lane);
        for (int m = 0; m < 4 && !done; ++m) done = conv_matrix<0>(it, P.ffn_out + (size_t)m * DFF * DM, DM, DFF, DM, (h16*)(wb + W_FO + m * W_FO_SZ), scr, lane);
        for (int m = 0; m < 2 && !done; ++m) done = conv_matrix<0>(it, P.ple_in + (size_t)m * PLED * DM, DM, PLED, DM, (h16*)(wb + W_PI + m * W_PI_SZ), scr, lane);
        for (int m = 0; m < 2 && !done; ++m) done = conv_matrix<0>(it, P.ple_gate + (size_t)m * DM * DM, DM, DM, DM, (h16*)(wb + W_PG + m * W_SQ_SZ), scr, lane);
        if (!done) done = conv_matrix<2>(it, P.nsa_in, NSA_IN, DM, NSA_NP, (h16*)(wb + W_NI), scr, lane);
        if (!done) done = conv_matrix<0>(it, P.nsa_out, DM, DM, DM, (h16*)(wb + W_NO), scr, lane);
        if (!done) done = conv_matrix<0>(it, P.hg_in, 4096, DM, 4096, (h16*)(wb + W_HI), scr, lane);
        if (!done) done = conv_matrix<0>(it, P.hg_out, DM, DM, DM, (h16*)(wb + W_HO), scr, lane);
        for (int m = 0; m < 2 && !done; ++m) done = conv_matrix<0>(it, P.cmp_w1 + (size_t)m * 2048 * 64, 64, 2048, 64, (h16*)(wb + W_C1 + m * W_C1_SZ), scr, lane);
        for (int m = 0; m < 2 && !done; ++m) done = conv_matrix<0>(it, P.cmp_w2 + (size_t)m * 64 * 64, 64, 64, 64, (h16*)(wb + W_C2 + m * W_C2_SZ), scr, lane);
    }
    h16* Hb = (h16*)(P.ws + WS_H);
    for (int m = gw; m < T; m += NGW) rms_row_to_h16(P.x + (size_t)m * DM, P.ng, Hb + (size_t)m * DM, nullptr, lane);
    { const size_t n4 = (size_t)DEPTH * T * PLED / 4; const GAS f32x4* src = (const GAS f32x4*)P.p; GAS u32x2* dst = (GAS u32x2*)(P.ws + WS_PH);
      for (size_t i = (size_t)gw * 64 + lane; i < n4; i += (size_t)NGW * 64) { const f32x4 v = src[i]; u32x2 o; o.x = pkh(v.x, v.y); o.y = pkh(v.z, v.w); dst[i] = o; } }
    { float* rc = (float*)(P.ws + WS_ROPE_C); float* rs = (float*)(P.ws + WS_ROPE_S);
      for (int i = gw * 64 + lane; i < SEQ * 32; i += NGW * 64) { const int pos = i >> 5, k = i & 31;
          const float inv = (float)pow(10000.0, -(double)k / 32.0); const float ang = (float)pos * inv;
          rc[i] = (float)cos((double)ang); rs[i] = (float)sin((double)ang); } }
    { float* lb = (float*)(P.ws + WS_MISC + 4096);
      for (int i = gw * 64 + lane; i < 1024; i += NGW * 64) { const float l0 = P.hg_lb[i], l1 = P.hg_lb[1024 + i]; const float mx = fmaxf(l0, l1);
          const float e0 = expf(l0 - mx), e1 = expf(l1 - mx); lb[i] = e1 / (e0 + e1); } }
    if (gw < 128) { const int kv = gw >> 6, o = gw & 63; const float* pos = P.cmp_pos + kv * 2048; const float* w1 = P.cmp_w1 + (size_t)kv * 2048 * 64;
        float s = 0.f; for (int k = lane; k < 2048; k += 64) s += pos[k] * w1[(size_t)k * 64 + o];
        s = wave_sum(s); if (lane == 0) ((float*)(P.ws + WS_MISC))[gw] = s; }
}

DI void thin_phase(const float* xin, float* x, const h16* y, const float* gpost, float alpha, const float* gpre, h16* hout, int vcu, int G, int wave, int lane) {
    const int gw = vcu * NWAVES + wave, NGW = G * NWAVES;
    f32x4 gp[4], gq[4];
#pragma unroll
    for (int j = 0; j < 2; ++j) { gp[2 * j] = ((const GAS f32x4*)gpost)[2 * lane + 128 * j]; gp[2 * j + 1] = ((const GAS f32x4*)gpost)[2 * lane + 1 + 128 * j];
        if (gpre) { gq[2 * j] = ((const GAS f32x4*)gpre)[2 * lane + 128 * j]; gq[2 * j + 1] = ((const GAS f32x4*)gpre)[2 * lane + 1 + 128 * j]; } }
    for (int m = gw; m < T; m += NGW) {
        GAS f32x4* xr = (GAS f32x4*)(x + (size_t)m * DM); const GAS f32x4* xi = (const GAS f32x4*)(xin + (size_t)m * DM); const GAS h16x8* yr = (const GAS h16x8*)(y + (size_t)m * DM);
        f32x4 xv[4], yv[4]; float s = 0.f;
#pragma unroll
        for (int j = 0; j < 2; ++j) { const h16x8 t = yr[lane + 64 * j];
            yv[2 * j] = (f32x4){(float)t[0], (float)t[1], (float)t[2], (float)t[3]}; yv[2 * j + 1] = (f32x4){(float)t[4], (float)t[5], (float)t[6], (float)t[7]};
            xv[2 * j] = xi[2 * lane + 128 * j]; xv[2 * j + 1] = xi[2 * lane + 1 + 128 * j]; }
#pragma unroll
        for (int j = 0; j < 4; ++j) s += (yv[j].x * yv[j].x + yv[j].y * yv[j].y) + (yv[j].z * yv[j].z + yv[j].w * yv[j].w);
        const float r = rsqrtf(wave_sum(s) * (1.f / DM) + NORM_EPS) * alpha; float s2 = 0.f;
#pragma unroll
        for (int j = 0; j < 4; ++j) { xv[j] = xv[j] + yv[j] * r * gp[j]; s2 += (xv[j].x * xv[j].x + xv[j].y * xv[j].y) + (xv[j].z * xv[j].z + xv[j].w * xv[j].w); }
#pragma unroll
        for (int j = 0; j < 2; ++j) { xr[2 * lane + 128 * j] = xv[2 * j]; xr[2 * lane + 1 + 128 * j] = xv[2 * j + 1]; }
        if (gpre) { const float r2 = rsqrtf(wave_sum(s2) * (1.f / DM) + NORM_EPS);
#pragma unroll
            for (int j = 0; j < 2; ++j) *(GAS u32x4*)(hout + (size_t)m * DM + 8 * lane + 512 * j) = pkh8(xv[2 * j] * r2 * gq[2 * j], xv[2 * j + 1] * r2 * gq[2 * j + 1]); }
    }
}

struct EpiPlain {
    static constexpr bool PERM = true, AFTER_DRAIN = false;
    h16* O; int ldc;
    DI void operator()(const f32x4 (&acc)[2][2][4][2], const pg8::Unit& u, int wr, int wc, int fr_, int fq_) const {
        int fr = fr_, fq = fq_; asm volatile("" : "+v"(fr), "+v"(fq));
        const int row0 = u.pm * 256 + wr * 64 + fr, col0 = u.pn * 256 + wc * 32 + 8 * fq;
#pragma unroll
        for (int ai = 0; ai < 2; ++ai)
#pragma unroll
            for (int m = 0; m < 4; ++m) { h16* rowp = O + (size_t)(row0 + ai * 128 + m * 16) * ldc + col0;
#pragma unroll
                for (int bj = 0; bj < 2; ++bj) *(GAS u32x4*)(rowp + bj * 128) = pkh8(acc[ai][bj][m][0], acc[ai][bj][m][1]); }
    }
};
struct EpiSwiglu {
    static constexpr bool PERM = true, AFTER_DRAIN = false;
    h16* O;
    DI void operator()(const f32x4 (&acc)[2][2][4][2], const pg8::Unit& u, int wr, int wc, int fr_, int fq_) const {
        int fr = fr_, fq = fq_; asm volatile("" : "+v"(fr), "+v"(fq));
        const int row0 = u.pm * 256 + wr * 64 + fr, col0 = u.pn * 128 + wc * 32 + 8 * fq;
#pragma unroll
        for (int ai = 0; ai < 2; ++ai)
#pragma unroll
            for (int m = 0; m < 4; ++m) { f32x4 v[2];
#pragma unroll
                for (int n = 0; n < 2; ++n)
#pragma unroll
                    for (int i = 0; i < 4; ++i) v[n][i] = siluf_(acc[ai][0][m][n][i]) * acc[ai][1][m][n][i];
                *(GAS u32x4*)(O + (size_t)(row0 + ai * 128 + m * 16) * DFF + col0) = pkh8(v[0], v[1]); }
    }
};
struct EpiPleGate {
    static constexpr bool PERM = true, AFTER_DRAIN = false;
    const h16* PE; h16* O;
    DI void operator()(const f32x4 (&acc)[2][2][4][2], const pg8::Unit& u, int wr, int wc, int fr_, int fq_) const {
        int fr = fr_, fq = fq_; asm volatile("" : "+v"(fr), "+v"(fq));
        const int row0 = u.pm * 256 + wr * 64 + fr, col0 = u.pn * 256 + wc * 32 + 8 * fq;
#pragma unroll
        for (int ai = 0; ai < 2; ++ai)
#pragma unroll
            for (int m = 0; m < 4; ++m)
#pragma unroll
                for (int bj = 0; bj < 2; ++bj) { const size_t off = (size_t)(row0 + ai * 128 + m * 16) * DM + col0 + bj * 128;
                    asm volatile("" ::: "memory");
                    const h16x8 pe = *(const GAS h16x8*)(PE + off); f32x4 v[2];
#pragma unroll
                    for (int n = 0; n < 2; ++n)
#pragma unroll
                        for (int i = 0; i < 4; ++i) v[n][i] = (float)pe[4 * n + i] * sigmoidf_(acc[ai][bj][m][n][i]);
                    *(GAS u32x4*)(O + off) = pkh8(v[0], v[1]); }
    }
};
struct EpiNsaIn {
    static constexpr bool PERM = true, AFTER_DRAIN = false;
    unsigned char* xb; const float* rc; const float* rs;
    DI void operator()(const f32x4 (&acc)[2][2][4][2], const pg8::Unit& u, int wr, int wc, int fr_, int fq_) const {
        int fr = fr_, fq = fq_; asm volatile("" : "+v"(fr), "+v"(fq));
        const int row0 = u.pm * 256 + wr * 64 + fr; const int pn = u.pn;
        if (pn == 10) {
            float* gt = (float*)(xb + X_GATES); const int j0 = wc * 32 + 8 * fq;
#pragma unroll
            for (int ai = 0; ai < 2; ++ai)
#pragma unroll
                for (int m = 0; m < 4; ++m) { const int row = row0 + ai * 128 + m * 16;
#pragma unroll
                    for (int n = 0; n < 2; ++n) { const int j = j0 + 4 * n; if (j < 48) { f32x4 g;
#pragma unroll
                        for (int i = 0; i < 4; ++i) g[i] = sigmoidf_(acc[ai][0][m][n][i]);
                        *(GAS f32x4*)(gt + (size_t)row * 48 + j) = g; } } }
            return;
        }
        const bool rope = (pn < 4) || pn == 4 || pn == 6 || pn == 8;
        const float sc = (pn < 4) ? 0.125f * LOG2E : 1.0f;
        h16* dst; int ld, colb;
        if (pn < 4) { dst = (h16*)(xb + X_Q); ld = 1024; colb = (4 * pn + wc) * 64; }
        else { dst = (h16*)(xb + X_KC + (size_t)(pn - 4) * 16 * MiB); ld = 64; colb = 0; }
        const int d0 = 8 * fq;
#pragma unroll
        for (int ai = 0; ai < 2; ++ai)
#pragma unroll
            for (int m = 0; m < 4; ++m) { const int row = row0 + ai * 128 + m * 16;
                asm volatile("" ::: "memory");
                f32x4 o1[2], o2[2];
                if (rope) { const int pos = row & (SEQ - 1);
#pragma unroll
                    for (int n = 0; n < 2; ++n) { const f32x4 c = *(const GAS f32x4*)(rc + pos * 32 + d0 + 4 * n), s = *(const GAS f32x4*)(rs + pos * 32 + d0 + 4 * n);
                        const f32x4 x1 = acc[ai][0][m][n], x2 = acc[ai][1][m][n];
                        o1[n] = (x1 * c - x2 * s) * sc; o2[n] = (x2 * c + x1 * s) * sc; } }
                else { o1[0] = acc[ai][0][m][0]; o1[1] = acc[ai][0][m][1]; o2[0] = acc[ai][1][m][0]; o2[1] = acc[ai][1][m][1]; }
                const size_t rrow = (pn < 4) ? (size_t)row : ((size_t)((row >> 14) * NG + wc) * SEQ + (row & (SEQ - 1)));
                h16* rp = dst + rrow * ld + colb + d0;
                *(GAS u32x4*)(rp) = pkh8(o1[0], o1[1]); *(GAS u32x4*)(rp + 32) = pkh8(o2[0], o2[1]); }
    }
};
struct EpiHgIn {
    static constexpr bool PERM = true, AFTER_DRAIN = false;
    unsigned char* xb; h16* GH; const float* lb;
    DI void operator()(const f32x4 (&acc)[2][2][4][2], const pg8::Unit& u, int wr, int wc, int fr_, int fq_) const {
        int fr = fr_, fq = fq_; asm volatile("" : "+v"(fr), "+v"(fq));
        const int row0 = u.pm * 256 + wr * 64 + fr; const int kind = u.pn >> 2; const int col0 = (u.pn & 3) * 256 + wc * 32 + 8 * fq;
        h16* dst = kind == 0 ? (h16*)(xb + X_QH) : kind == 1 ? (h16*)(xb + X_LF) : kind == 2 ? (h16*)(xb + X_VH) : GH;
        f32x4 lbv[2][2];
        if (kind == 1) {
#pragma unroll
            for (int bj = 0; bj < 2; ++bj)
#pragma unroll
                for (int n = 0; n < 2; ++n) lbv[bj][n] = *(const GAS f32x4*)(lb + col0 + bj * 128 + 4 * n); }
#pragma unroll
        for (int ai = 0; ai < 2; ++ai)
#pragma unroll
            for (int m = 0; m < 4; ++m)
#pragma unroll
                for (int bj = 0; bj < 2; ++bj) { f32x4 v[2];
                    asm volatile("" ::: "memory");
#pragma unroll
                    for (int n = 0; n < 2; ++n)
#pragma unroll
                        for (int i = 0; i < 4; ++i) { const float a = acc[ai][bj][m][n][i]; float r;
                            if (kind == 0 || kind == 3) r = siluf_(a);
                            else if (kind == 1) { const float l = lbv[bj][n][i]; r = __logf(l + (1.f - l) * sigmoidf_(a)); }
                            else r = a;
                            v[n][i] = r; }
                    *(GAS u32x4*)(dst + (size_t)(row0 + ai * 128 + m * 16) * DM + col0 + bj * 128) = pkh8(v[0], v[1]); }
    }
};

constexpr int CX_STR = 72;
DI void compress_phase(unsigned char* ws, LAS unsigned char* lds, int wgi, int G, int tid) {
    const int wave = __builtin_amdgcn_readfirstlane(tid >> 6), lane = tid & 63, fr = lane & 15, fq = lane >> 4;
    LAS h16* X = (LAS h16*)lds;
    LAS h16* MID = (LAS h16*)(lds + 528 * CX_STR * 2);
    const int mt = wave >> 2, nt = wave & 3;
    for (int u = wgi; u < 512; u += G) {
        const int kv = u >> 8, b = (u >> 7) & 1, g = (u >> 5) & 3, nb = u & 31, n0 = 32 * nb;
        const h16* src = (const h16*)(ws + WS_X + (kv ? X_VC : X_KC)) + (size_t)(b * NG + g) * SEQ * 64;
        for (int i = tid; i < 528 * 8; i += NTHREADS) { const int r = i >> 3, ch = i & 7; int tok = 16 * n0 + r; tok = tok < SEQ ? tok : SEQ - 1;
            *(LAS u32x4*)(X + r * CX_STR + ch * 8) = *(const GAS u32x4*)(src + (size_t)tok * 64 + ch * 8); }
        __syncthreads();
        const h16* w1t = (const h16*)(ws + WS_W + W_C1 + kv * W_C1_SZ) + (size_t)(16 * nt + fr) * 2048 + 8 * fq;
        f32x4 acc = {0.f, 0.f, 0.f, 0.f};
#pragma unroll 16
        for (int s = 0; s < 64; ++s) {
            const h16x8 a = *(const LAS h16x8*)(X + (16 * (16 * mt + fr) + (s >> 1)) * CX_STR + 32 * (s & 1) + 8 * fq);
            const h16x8 bw = *(const GAS h16x8*)(w1t + 32 * s);
            acc = __builtin_amdgcn_mfma_f32_16x16x32_f16(a, bw, acc, 0, 0, 0);
        }
        const float bias = ((const float*)(ws + WS_MISC))[kv * 64 + 16 * nt + fr];
#pragma unroll
        for (int i = 0; i < 4; ++i) MID[(16 * mt + 4 * fq + i) * CX_STR + 16 * nt + fr] = (h16)siluf_(acc[i] + bias);
        __syncthreads();
        const h16* w2t = (const h16*)(ws + WS_W + W_C2 + kv * W_C2_SZ) + (size_t)(16 * nt + fr) * 64 + 8 * fq;
        f32x4 acc2 = {0.f, 0.f, 0.f, 0.f};
#pragma unroll
        for (int s = 0; s < 2; ++s) {
            const h16x8 a = *(const LAS h16x8*)(MID + (16 * mt + fr) * CX_STR + 32 * s + 8 * fq);
            const h16x8 bw = *(const GAS h16x8*)(w2t + 32 * s);
            acc2 = __builtin_amdgcn_mfma_f32_16x16x32_f16(a, bw, acc2, 0, 0, 0);
        }
        h16* dst = (h16*)(ws + WS_X + (kv ? X_VCMP : X_KCMP)) + (size_t)(b * NG + g) * NCMP_P * 64;
#pragma unroll
        for (int i = 0; i < 4; ++i) { const int n = n0 + 16 * mt + 4 * fq + i; dst[(size_t)n * 64 + 16 * nt + fr] = (n < NCMP) ? (h16)acc2[i] : (h16)0.f; }
        __syncthreads();
    }
}

constexpr int AT_IMP = 49152, AT_SELM = LDSCTL_OFF + 1024, AT_END = AT_SELM + 2048;
static_assert(AT_IMP + 65536 <= RING_BYTES && AT_END <= LDS_BYTES, "attention LDS map");
constexpr float M_INIT = -1e30f, M_MASK = -3e30f;

DI int opaque(int x) { asm volatile("" : "+v"(x)); return x; }
#define WG_BAR() do { asm volatile("s_waitcnt lgkmcnt(0)" ::: "memory"); __builtin_amdgcn_s_barrier(); asm volatile("" ::: "memory"); } while (0)

DI float quad_sum(float v) {
    v += __builtin_bit_cast(float, __builtin_amdgcn_update_dpp(0, __builtin_bit_cast(int, v), 0xB1, 0xF, 0xF, true));
    v += __builtin_bit_cast(float, __builtin_amdgcn_update_dpp(0, __builtin_bit_cast(int, v), 0x4E, 0xF, 0xF, true));
    return v;
}
DI float col_max(float v) {
    const auto a = __builtin_amdgcn_permlane16_swap(__float_as_uint(v), __float_as_uint(v), false, false);
    const unsigned a0 = a[0], a1 = a[1];
    v = fmaxf(__uint_as_float(a0), __uint_as_float(a1));
    const auto b = __builtin_amdgcn_permlane32_swap(__float_as_uint(v), __float_as_uint(v), false, false);
    const unsigned b0 = b[0], b1 = b[1];
    return fmaxf(__uint_as_float(b0), __uint_as_float(b1));
}
DI float col_sum(float v) { v += __shfl_xor(v, 16); v += __shfl_xor(v, 32); return v; }

DI void glds16(const void* gsrc, unsigned lds_dst) { unsigned keep;
    asm volatile("s_mov_b32 %0, m0\n\ts_mov_b32 m0, %2\n\ts_nop 0\n\tglobal_load_lds_dwordx4 %1, off\n\ts_mov_b32 m0, %0" : "=&s"(keep) : "v"(gsrc), "s"(lds_dst) : "memory"); }
DI void sel_dma_tile(const h16* Kg, const h16* Vg, int ld, int t, LAS unsigned char* slot, int wave, int lane) {
    lane = opaque(lane);
    const int rl = lane >> 3, row = 8 * wave + rl, ch = (lane & 7) ^ rl;
    const unsigned goff = (unsigned)(((64 * t + row) * ld + ch * 8) * 2);
    const unsigned dst = (unsigned)(uintptr_t)(slot + wave * 1024);
    glds16((const char*)Kg + goff, dst);
    glds16((const char*)Vg + goff, dst + 8192u);
}
DI void at_kread(h16x8 (&kf)[8], const LAS h16* Kb, int fr, int fq) {
    const int r7 = fr & 7;
#pragma unroll
    for (int kb = 0; kb < 4; ++kb) { kf[2 * kb] = *(const LAS h16x8*)(Kb + (16 * kb + fr) * 64 + ((fq ^ r7) * 8)); kf[2 * kb + 1] = *(const LAS h16x8*)(Kb + (16 * kb + fr) * 64 + (((4 + fq) ^ r7) * 8)); }
    __builtin_amdgcn_sched_barrier(0);
}
DI void at_qk_mma(f32x4 (&st)[2][4], const h16x8 (&kf)[8], const h16x8 (&qf)[2][2], const float (&bias)[2], bool need0, bool need1) {
#pragma unroll
    for (int kb = 0; kb < 4; ++kb) {
        if (need0) { const f32x4 z = {bias[0], bias[0], bias[0], bias[0]}; st[0][kb] = __builtin_amdgcn_mfma_f32_16x16x32_f16(kf[2 * kb], qf[0][0], z, 0, 0, 0); st[0][kb] = __builtin_amdgcn_mfma_f32_16x16x32_f16(kf[2 * kb + 1], qf[0][1], st[0][kb], 0, 0, 0); }
        if (need1) { const f32x4 z = {bias[1], bias[1], bias[1], bias[1]}; st[1][kb] = __builtin_amdgcn_mfma_f32_16x16x32_f16(kf[2 * kb], qf[1][0], z, 0, 0, 0); st[1][kb] = __builtin_amdgcn_mfma_f32_16x16x32_f16(kf[2 * kb + 1], qf[1][1], st[1][kb], 0, 0, 0); }
    }
}
DI void at_vread(h16x8 (&vf)[8], const LAS h16* Vb, int fr, int fq) {
    const int q = fr >> 2, k7 = 4 * (fq & 1) + q, cl = (fr & 3) >> 1, in4 = 4 * (fr & 1);
#pragma unroll
    for (int s2 = 0; s2 < 2; ++s2)
#pragma unroll
        for (int db = 0; db < 4; ++db) {
            const LAS h16* p0 = Vb + (32 * s2 + 4 * fq + q) * 64 + (((2 * db + cl) ^ k7) * 8) + in4;
            const s16x4 r0 = __builtin_amdgcn_ds_read_tr16_b64_v4i16((LAS s16x4*)p0);
            const s16x4 r1 = __builtin_amdgcn_ds_read_tr16_b64_v4i16((LAS s16x4*)(p0 + 16 * 64));
            vf[4 * s2 + db] = __builtin_bit_cast(h16x8, __builtin_shufflevector(r0, r1, 0, 1, 2, 3, 4, 5, 6, 7)); }
    __builtin_amdgcn_sched_barrier(0);
}
DI void at_pv_mma(f32x4 (&o)[2][4], const h16x8 (&vf)[8], const h16x8 (&pb)[2][2], bool need0, bool need1) {
#pragma unroll
    for (int s2 = 0; s2 < 2; ++s2)
#pragma unroll
        for (int db = 0; db < 4; ++db) {
            if (need0) o[0][db] = __builtin_amdgcn_mfma_f32_16x16x32_f16(vf[4 * s2 + db], pb[0][s2], o[0][db], 0, 0, 0);
            if (need1) o[1][db] = __builtin_amdgcn_mfma_f32_16x16x32_f16(vf[4 * s2 + db], pb[1][s2], o[1][db], 0, 0, 0);
        }
}
DI h16x8 pack_p(const f32x4& a, const f32x4& b) { return __builtin_bit_cast(h16x8, pkh8(a, b)); }
DI void at_softmax(f32x4 (&st)[4], float& mrun, float& lrun, f32x4 (&o)[4], h16x8 (&pb)[2]) {
    float tmax = fmaxf(fmaxf(fmaxf(st[0][0], st[0][1]), fmaxf(st[0][2], st[0][3])), fmaxf(fmaxf(st[1][0], st[1][1]), fmaxf(st[1][2], st[1][3])));
    tmax = fmaxf(tmax, fmaxf(fmaxf(fmaxf(st[2][0], st[2][1]), fmaxf(st[2][2], st[2][3])), fmaxf(fmaxf(st[3][0], st[3][1]), fmaxf(st[3][2], st[3][3]))));
    tmax = col_max(tmax);
    const float mn = fmaxf(mrun, tmax), alpha = __builtin_amdgcn_exp2f(mrun - mn); float sum = 0.f;
#pragma unroll
    for (int kb = 0; kb < 4; ++kb)
#pragma unroll
        for (int i = 0; i < 4; ++i) { const float pp = __builtin_amdgcn_exp2f(st[kb][i] - mn); st[kb][i] = pp; sum += pp; }
    lrun = lrun * alpha + sum; mrun = mn;
#pragma unroll
    for (int db = 0; db < 4; ++db) o[db] = o[db] * alpha;
    pb[0] = pack_p(st[0], st[1]); pb[1] = pack_p(st[2], st[3]);
}
#define DN_PIPE_BEGIN(Kg, Vg, ld, first, last)                                                                           \
    { sel_dma_tile(Kg, Vg, ld, (first), lds, wave, lane);                                                                \
      if ((first) + 1 <= (last)) sel_dma_tile(Kg, Vg, ld, (first) + 1, lds + 16384, wave, lane);                         \
      int sl_ = 0;                                                                                                       \
      for (int t_ = (first); t_ <= (last); ++t_) {                                                                       \
          if (t_ + 1 <= (last)) asm volatile("s_waitcnt vmcnt(2)" ::: "memory"); else asm volatile("s_waitcnt vmcnt(0)" ::: "memory");   \
          WG_BAR();                                                                                                      \
          { const int s2_ = sl_ >= 1 ? sl_ - 1 : 2; if (t_ + 2 <= (last)) sel_dma_tile(Kg, Vg, ld, t_ + 2, lds + s2_ * 16384, wave, lane); }   \
          const LAS h16* Kb = (const LAS h16*)(lds + sl_ * 16384); const LAS h16* Vb = Kb + 4096; (void)Vb;
#define DN_PIPE_END                                                                                                      \
          sl_ = sl_ == 2 ? 0 : sl_ + 1; }                                                                                \
      WG_BAR(); }

DI void attn_phase(unsigned char* ws, LAS unsigned char* lds, int wgi, int G, int tid) {
    const int wave = __builtin_amdgcn_readfirstlane(tid >> 6), lane = tid & 63, fr = lane & 15, fq = lane >> 4;
    const int tl = fr >> 2, hd = fr & 3;
    unsigned char* xb = ws + WS_X;
    LAS float* IMP = (LAS float*)(lds + AT_IMP) + wave * (8 * 256);
    LAS unsigned char* sb = (LAS unsigned char*)(lds + AT_SELM) + wave * 256;
    const float* gates = (const float*)(xb + X_GATES);
    for (int u = wgi; u < 2048; u += G) {
        const int bg = u & 7, b = bg >> 2, g = bg & 3, qq = u >> 3, ii = qq >> 5, rr = qq & 31;
        const int c = (ii & 1) ? (64 * (ii >> 1) + 63 - rr) : (64 * (ii >> 1) + rr);
        const size_t rowb = (size_t)b * SEQ;
        const int tw = 64 * c + 8 * wave;
        h16x8 qf[2][2];
#pragma unroll
        for (int a = 0; a < 2; ++a)
#pragma unroll
            for (int s = 0; s < 2; ++s)
                qf[a][s] = *(const GAS h16x8*)((const h16*)(xb + X_Q) + (rowb + tw + 4 * a + tl) * 1024 + (4 * g + hd) * 64 + 32 * s + 8 * fq);
        int tcol[2]; tcol[0] = tw + tl; tcol[1] = tw + 4 + tl;
        asm volatile("" :: "v"(qf[0][0]), "v"(qf[0][1]), "v"(qf[1][0]), "v"(qf[1][1]));
        GAS char* oscr = (GAS char*)(xb + X_OSCR + (size_t)wgi * 65536 + wave * 8192); const unsigned ooff = (unsigned)lane * 128u;
        const float zb[2] = {0.f, 0.f};
        {
            const h16* Kg = (const h16*)(xb + X_KCMP) + (size_t)(b * NG + g) * NCMP_P * 64;
            const h16* Vg = (const h16*)(xb + X_VCMP) + (size_t)(b * NG + g) * NCMP_P * 64;
            const int ntc = (4 * c + 3 + 63) >> 6;
            const int tfull = (4 * c - 2 + 1) >> 6;
            int nmax[2];
#pragma unroll
            for (int a = 0; a < 2; ++a) nmax[a] = (tcol[a] >= 31) ? ((tcol[a] - 31) >> 4) : -1;
            f32x4 o[2][4];
#ifndef REP_CMP
#define REP_CMP 1
#endif
            _Pragma("unroll 1") for (int rep_ = 0; rep_ < REP_CMP; ++rep_) {
            float mrun[2] = {M_INIT, M_INIT}, lrun[2] = {0.f, 0.f};
            PROF_BEGIN(1);
            DN_PIPE_BEGIN(Kg, Vg, 64, 0, ntc - 1)
                h16x8 kf[8]; at_kread(kf, Kb, fr, fq); f32x4 st[2][4]; at_qk_mma(st, kf, qf, zb, true, true);
#pragma unroll
                for (int a = 0; a < 2; ++a) {
                    if (t_ >= tfull) {
#pragma unroll
                        for (int kb = 0; kb < 4; ++kb)
#pragma unroll
                            for (int i = 0; i < 4; ++i) { const int n = 64 * t_ + 16 * kb + 4 * fq + i; st[a][kb][i] = (n <= nmax[a]) ? st[a][kb][i] : M_MASK; }
                    }
                    float tmax = fmaxf(fmaxf(fmaxf(st[a][0][0], st[a][0][1]), fmaxf(st[a][0][2], st[a][0][3])), fmaxf(fmaxf(st[a][1][0], st[a][1][1]), fmaxf(st[a][1][2], st[a][1][3])));
                    tmax = fmaxf(tmax, fmaxf(fmaxf(fmaxf(st[a][2][0], st[a][2][1]), fmaxf(st[a][2][2], st[a][2][3])), fmaxf(fmaxf(st[a][3][0], st[a][3][1]), fmaxf(st[a][3][2], st[a][3][3]))));
                    const float mn = fmaxf(mrun[a], tmax); float sum = 0.f;
#pragma unroll
                    for (int kb = 0; kb < 4; ++kb)
#pragma unroll
                        for (int i = 0; i < 4; ++i) sum += __builtin_amdgcn_exp2f(st[a][kb][i] - mn);
                    lrun[a] = lrun[a] * __builtin_amdgcn_exp2f(mrun[a] - mn) + sum; mrun[a] = mn;
                }
            DN_PIPE_END
            PROF_END(1);
            float mcol[2], invl[2];
            PROF_BEGIN(2);
#pragma unroll
            for (int a = 0; a < 2; ++a) { const float mc = col_max(mrun[a]); const float lc = col_sum(lrun[a] * __builtin_amdgcn_exp2f(mrun[a] - mc)); mcol[a] = mc; invl[a] = 1.0f / fmaxf(lc, 1e-30f); }
#pragma unroll
            for (int a = 0; a < 2; ++a)
#pragma unroll
                for (int db = 0; db < 4; ++db) o[a][db] = (f32x4){0.f, 0.f, 0.f, 0.f};
            float carry[2] = {0.f, 0.f};
            const float nb2[2] = {-mcol[0], -mcol[1]};
            DN_PIPE_BEGIN(Kg, Vg, 64, 0, ntc - 1)
                h16x8 kf[8]; at_kread(kf, Kb, fr, fq); f32x4 st[2][4]; at_qk_mma(st, kf, qf, nb2, true, true);
                h16x8 vf[8]; at_vread(vf, Vb, fr, fq);
                h16x8 pb[2][2];
#pragma unroll
                for (int a = 0; a < 2; ++a) {
#pragma unroll
                    for (int kb = 0; kb < 4; ++kb)
#pragma unroll
                        for (int i = 0; i < 4; ++i) { const int n = 64 * t_ + 16 * kb + 4 * fq + i; const float e = __builtin_amdgcn_exp2f(st[a][kb][i]) * invl[a]; st[a][kb][i] = (t_ < tfull || n <= nmax[a]) ? e : 0.f; }
                    pb[a][0] = pack_p(st[a][0], st[a][1]); pb[a][1] = pack_p(st[a][2], st[a][3]);
                    if (c > 15) {
                        const int ln = opaque(lane), fq_ = ln >> 4, hd_ = ln & 3, tl_ = (ln & 15) >> 2;
                        float s4[4], p3[4], tt[4];
#pragma unroll
                        for (int kb = 0; kb < 4; ++kb) { s4[kb] = quad_sum((st[a][kb][0] + st[a][kb][1]) + (st[a][kb][2] + st[a][kb][3])); p3[kb] = quad_sum(st[a][kb][3]); }
#pragma unroll
                        for (int kb = 0; kb < 4; ++kb) tt[kb] = __shfl(p3[kb], (ln + 48) & 63);
#pragma unroll
                        for (int kb = 0; kb < 4; ++kb) { const float recv = (fq_ > 0) ? tt[kb] : (kb > 0 ? tt[kb > 0 ? kb - 1 : 0] : carry[a]);
                            const int j = 16 * t_ + 4 * kb + fq_;
                            if (hd_ == 0 && j < 256) IMP[(4 * a + tl_) * 256 + j] = s4[kb] + recv; }
                        carry[a] = tt[3];
                    }
                }
                at_pv_mma(o, vf, pb, true, true);
            DN_PIPE_END
            }
#pragma unroll
            for (int a = 0; a < 2; ++a) { const float gt = gates[(rowb + tcol[a]) * 48 + (4 * g + hd) * 3 + 0];
#pragma unroll
                for (int db = 0; db < 4; ++db) *(GAS f32x4*)(oscr + (a * 4 + db) * 16 + ooff) = o[a][db] * gt; }
        }
        PROF_END(2);
        PROF_BEGIN(3);
#ifndef REP_TOPK
#define REP_TOPK 1
#endif
        for (int rep_ = 0; rep_ < REP_TOPK; ++rep_) {
            const int lane = opaque(tid) & 63;
            unsigned bytes[4] = {0u, 0u, 0u, 0u};
            if (c <= 15) {
#pragma unroll
                for (int k = 0; k < 4; ++k) bytes[k] = (lane + 64 * k <= c) ? 0xFFu : 0u;
            } else {
#pragma unroll 1
                for (int tk0 = 0; tk0 < 8; tk0 += 4) {
                    unsigned key[4][4];
#pragma unroll
                    for (int q4 = 0; q4 < 4; ++q4)
#pragma unroll
                        for (int k = 0; k < 4; ++k) { const int j = lane + 64 * k; const unsigned ub = __builtin_bit_cast(unsigned, IMP[(tk0 + q4) * 256 + j]);
                            key[q4][k] = (j >= 1 && j <= c - 2) ? (((ub >> 7) << 8) | (unsigned)(255 - j)) : 0u; }
                    unsigned thr[4] = {0u, 0u, 0u, 0u};
#pragma unroll 1
                    for (int bit = 31; bit >= 0; --bit) {
#pragma unroll
                        for (int q4 = 0; q4 < 4; ++q4) { const unsigned cand = thr[q4] | (1u << bit); int cnt = 0;
#pragma unroll
                            for (int k = 0; k < 4; ++k) cnt += __popcll(__ballot(key[q4][k] >= cand));
                            if (cnt >= 13) thr[q4] = cand; } }
#pragma unroll
                    for (int q4 = 0; q4 < 4; ++q4)
#pragma unroll
                        for (int k = 0; k < 4; ++k) bytes[k] |= (key[q4][k] >= thr[q4] && key[q4][k] != 0u) ? (1u << (tk0 + q4)) : 0u;
                }
#pragma unroll
                for (int k = 0; k < 4; ++k) { const int j = lane + 64 * k; if (j == 0 || j == c || j == c - 1) bytes[k] = 0xFFu; }
            }
#pragma unroll
            for (int k = 0; k < 4; ++k) sb[lane + 64 * k] = (unsigned char)bytes[k];
        }
        WG_BAR();
        PROF_END(3); PROF_BEGIN(4);
        {
            const h16* Kg = (const h16*)(xb + X_KS) + (size_t)(b * NG + g) * SEQ * 64;
            const h16* Vg = (const h16*)(xb + X_VS) + (size_t)(b * NG + g) * SEQ * 64;
            float mrun[2], lrun[2];
            f32x4 o[2][4];
            const int nblk = c + 1, nbatch = (nblk + 3) >> 2;
#ifndef REP_SEL
#define REP_SEL 1
#endif
            for (int rep_ = 0; rep_ < REP_SEL; ++rep_) {
            mrun[0] = mrun[1] = M_INIT; lrun[0] = lrun[1] = 0.f;
#pragma unroll
            for (int a = 0; a < 2; ++a)
#pragma unroll
                for (int db = 0; db < 4; ++db) o[a][db] = (f32x4){0.f, 0.f, 0.f, 0.f};
#pragma unroll
            for (int bb = 0; bb < 4; ++bb) if (bb < nblk) sel_dma_tile(Kg, Vg, 64, bb, lds + bb * 16384, wave, lane);
            for (int e = 0; e < nbatch; ++e) {
                PROF_BEGIN(6); asm volatile("s_waitcnt vmcnt(0)" ::: "memory"); PROF_END(6); PROF_BEGIN(7); WG_BAR(); PROF_END(7);
                if (e + 1 < nbatch) {
#pragma unroll
                    for (int bb = 0; bb < 4; ++bb) { const int j = 4 * (e + 1) + bb; if (j < nblk) sel_dma_tile(Kg, Vg, 64, j, lds + (((e + 1) & 1) * 4 + bb) * 16384, wave, lane); } }
#pragma unroll 1
                for (int bb = 0; bb < 4; ++bb) {
                    const int j = 4 * e + bb; if (j >= nblk) break;
                    const unsigned tm = (unsigned)__builtin_amdgcn_readfirstlane((int)sb[j]);
                    const bool need0 = (tm & 0xFu) != 0u, need1 = (tm & 0xF0u) != 0u;
                    if (need0 || need1) {
                        const LAS h16* Kb = (const LAS h16*)(lds + ((e & 1) * 4 + bb) * 16384); const LAS h16* Vb = Kb + 4096;
                        float bias[2];
#pragma unroll
                        for (int a = 0; a < 2; ++a) bias[a] = ((tm >> (4 * a + tl)) & 1u) ? 0.f : M_MASK;
                        h16x8 kf[8]; at_kread(kf, Kb, fr, fq); f32x4 st[2][4]; at_qk_mma(st, kf, qf, bias, need0, need1);
                        h16x8 vf[8]; at_vread(vf, Vb, fr, fq);
                        h16x8 pb[2][2];
#pragma unroll
                        for (int a = 0; a < 2; ++a) {
                            const bool need = a ? need1 : need0;
                            if (need) {
                                if (j == c) { const int tloc = tcol[a] - 64 * c;
#pragma unroll
                                    for (int kb = 0; kb < 4; ++kb)
#pragma unroll
                                        for (int i = 0; i < 4; ++i) st[a][kb][i] = (16 * kb + 4 * fq + i <= tloc) ? st[a][kb][i] : M_MASK; }
                                at_softmax(st[a], mrun[a], lrun[a], o[a], pb[a]);
                            } else { pb[a][0] = (h16x8){0, 0, 0, 0, 0, 0, 0, 0}; pb[a][1] = pb[a][0]; }
                        }
                        at_pv_mma(o, vf, pb, need0, need1);
                    }
                }
            }
            WG_BAR();
            }
#pragma unroll
            for (int a = 0; a < 2; ++a) { const float gt = gates[(rowb + tcol[a]) * 48 + (4 * g + hd) * 3 + 1] / fmaxf(col_sum(lrun[a]), 1e-30f);
#pragma unroll
                for (int db = 0; db < 4; ++db) o[a][db] = o[a][db] * gt; }
            { f32x4 prev[2][4];
#pragma unroll
              for (int a = 0; a < 2; ++a)
#pragma unroll
                for (int db = 0; db < 4; ++db) prev[a][db] = *(const GAS f32x4*)(oscr + (a * 4 + db) * 16 + ooff);
#pragma unroll
              for (int a = 0; a < 2; ++a)
#pragma unroll
                for (int db = 0; db < 4; ++db) *(GAS f32x4*)(oscr + (a * 4 + db) * 16 + ooff) = prev[a][db] + o[a][db]; }
        }
        PROF_END(4); PROF_BEGIN(5);
        {
            const h16* Kg = (const h16*)(xb + X_KW) + (size_t)(b * NG + g) * SEQ * 64;
            const h16* Vg = (const h16*)(xb + X_VW) + (size_t)(b * NG + g) * SEQ * 64;
            float mrun[2], lrun[2];
            f32x4 o[2][4];
            const int j0 = c >= 8 ? c - 8 : 0;
#ifndef REP_WIN
#define REP_WIN 1
#endif
            for (int rep_ = 0; rep_ < REP_WIN; ++rep_) {
            mrun[0] = mrun[1] = M_INIT; lrun[0] = lrun[1] = 0.f;
#pragma unroll
            for (int a = 0; a < 2; ++a)
#pragma unroll
                for (int db = 0; db < 4; ++db) o[a][db] = (f32x4){0.f, 0.f, 0.f, 0.f};
            DN_PIPE_BEGIN(Kg, Vg, 64, j0, c)
                h16x8 kf[8]; at_kread(kf, Kb, fr, fq); f32x4 st[2][4]; at_qk_mma(st, kf, qf, zb, true, true);
                h16x8 vf[8]; at_vread(vf, Vb, fr, fq);
                h16x8 pb[2][2];
#pragma unroll
                for (int a = 0; a < 2; ++a) {
                    if (t_ == c || t_ == c - 8) {
#pragma unroll
                        for (int kb = 0; kb < 4; ++kb)
#pragma unroll
                            for (int i = 0; i < 4; ++i) { const int kt = 64 * t_ + 16 * kb + 4 * fq + i; st[a][kb][i] = ((kt <= tcol[a]) && (kt > tcol[a] - 512)) ? st[a][kb][i] : M_MASK; }
                    }
                    at_softmax(st[a], mrun[a], lrun[a], o[a], pb[a]);
                }
                at_pv_mma(o, vf, pb, true, true);
            DN_PIPE_END
            }
#pragma unroll
            for (int a = 0; a < 2; ++a) { const float gt = gates[(rowb + tcol[a]) * 48 + (4 * g + hd) * 3 + 2] / fmaxf(col_sum(lrun[a]), 1e-30f);
#pragma unroll
                for (int db = 0; db < 4; ++db) o[a][db] = o[a][db] * gt; }
            { f32x4 prev[2][4];
#pragma unroll
              for (int a = 0; a < 2; ++a)
#pragma unroll
                for (int db = 0; db < 4; ++db) prev[a][db] = *(const GAS f32x4*)(oscr + (a * 4 + db) * 16 + ooff);
#pragma unroll
              for (int a = 0; a < 2; ++a)
#pragma unroll
                for (int db = 0; db < 4; ++db) { const f32x4 ot = prev[a][db] + o[a][db];
                    u32x2 w; w.x = pkh(ot[0], ot[1]); w.y = pkh(ot[2], ot[3]);
                    *(GAS u32x2*)((h16*)(ws + WS_H) + (rowb + tcol[a]) * 1024 + (4 * g + hd) * 64 + 16 * db + 4 * fq) = w; } }
        }
        PROF_END(5);
    }
}

constexpr int HQ_STR = 136;
constexpr int HK_STR = 24;
constexpr int HL_QT = 0, HL_KT = HL_QT + 16 * HQ_STR * 2, HL_KH = HL_KT + 16 * HQ_STR * 2, HL_VT = HL_KH + 128 * HK_STR * 2;
constexpr int HL_DEC = HL_VT + 128 * HK_STR * 2, HL_PART = HL_DEC + 512, HL_RED = HL_PART + 2048, HL_END = HL_RED + 512;
template <bool OUT> DI void hgrn_phase(unsigned char* ws, const float* hg_norm, LAS unsigned char* lds, int wgi, int G, int tid) {
    const int wave = __builtin_amdgcn_readfirstlane(tid >> 6), lane = tid & 63, fr = lane & 15, fq = lane >> 4;
    unsigned char* xb = ws + WS_X;
    LAS __bf16* QT = (LAS __bf16*)(lds + HL_QT); LAS __bf16* KT = (LAS __bf16*)(lds + HL_KT);
    LAS __bf16* KH = (LAS __bf16*)(lds + HL_KH); LAS __bf16* VT = (LAS __bf16*)(lds + HL_VT);
    LAS float* DEC = (LAS float*)(lds + HL_DEC); LAS float* PART = (LAS float*)(lds + HL_PART); LAS float* RED = (LAS float*)(lds + HL_RED);
    const int d = tid & 127, part = tid >> 7;
    float* ST = (float*)(xb + X_ST); float* DT = (float*)(xb + X_DT);
    for (int u = wgi; u < 256; u += G) {
        const int b = u >> 7, h = (u >> 4) & 7, sc = u & 15;
        const size_t row0 = (size_t)b * SEQ + (size_t)sc * 1024;
        const h16* qg = (const h16*)(xb + X_QH) + row0 * DM + h * 128 + d;
        const h16* fg = (const h16*)(xb + X_LF) + row0 * DM + h * 128 + d;
        const h16* vg = (const h16*)(xb + X_VH) + row0 * DM + h * 128 + d;
        f32x4 S[8];
#pragma unroll
        for (int db = 0; db < 8; ++db) S[db] = (f32x4){0.f, 0.f, 0.f, 0.f};
        if (OUT) {
            for (int i = 0; i < sc; ++i) { const float* st = ST + (size_t)(u - sc + i) * 16384; const float* dt = DT + (size_t)(u - sc + i) * 128;
#pragma unroll
                for (int db = 0; db < 8; ++db) { const f32x4 dv = *(const GAS f32x4*)(dt + 16 * db + 4 * fq);
#pragma unroll
                    for (int k = 0; k < 4; ++k) S[db][k] = S[db][k] * dv[k] + st[(size_t)(16 * db + 4 * fq + k) * 128 + 16 * wave + fr]; } }
        }
        float qv[4], lv[4], vv[4]; float dsum = 0.f;
#pragma unroll
        for (int k = 0; k < 4; ++k) { const size_t o = (size_t)(4 * part + k) * DM; qv[k] = (float)qg[o]; lv[k] = (float)fg[o]; vv[k] = (float)vg[o]; }
        for (int step = 0; step < 64; ++step) {
            float cum[4]; cum[0] = lv[0]; cum[1] = cum[0] + lv[1]; cum[2] = cum[1] + lv[2]; cum[3] = cum[2] + lv[3];
            PART[part * 128 + d] = cum[3];
            __syncthreads();
            float off = 0.f, tot = 0.f;
#pragma unroll
            for (int pp = 0; pp < 4; ++pp) { const float v = PART[pp * 128 + d]; tot += v; if (pp < part) off += v; }
            { b16x4 qt, kt, kh, vt;
#pragma unroll
              for (int k = 0; k < 4; ++k) { const float bt = off + cum[k]; const float kk = -expm1f(lv[k]);
                  const float eb = __expf(bt);
                  if (OUT) { QT[(4 * part + k) * HQ_STR + d] = (__bf16)(qv[k] * eb); KT[(4 * part + k) * HQ_STR + d] = (__bf16)(kk * __expf(fminf(-bt, 80.f))); }
                  kh[k] = (__bf16)(kk * __expf(tot - bt)); vt[k] = (__bf16)vv[k]; }
              *(LAS b16x4*)(KH + d * HK_STR + 4 * part) = kh; *(LAS b16x4*)(VT + d * HK_STR + 4 * part) = vt; }
            if (part == 0) { DEC[d] = __expf(tot); dsum += tot; }
            if (step + 1 < 64) {
#pragma unroll
                for (int k = 0; k < 4; ++k) { const size_t o = (size_t)(16 * (step + 1) + 4 * part + k) * DM; qv[k] = (float)qg[o]; lv[k] = (float)fg[o]; vv[k] = (float)vg[o]; } }
            __syncthreads();
            f32x4 ot = {0.f, 0.f, 0.f, 0.f};
            if (OUT) {
                f32x4 at = {0.f, 0.f, 0.f, 0.f};
#pragma unroll
                for (int ks = 0; ks < 4; ++ks) { const b16x8 ka = *(const LAS b16x8*)(KT + fr * HQ_STR + 32 * ks + 8 * fq); const b16x8 qb = *(const LAS b16x8*)(QT + fr * HQ_STR + 32 * ks + 8 * fq);
                    at = __builtin_amdgcn_mfma_f32_16x16x32_bf16(ka, qb, at, 0, 0, 0); }
#pragma unroll
                for (int i = 0; i < 4; ++i) at[i] = (4 * fq + i <= fr) ? at[i] : 0.f;
                { const b16x4 v4 = *(const LAS b16x4*)(VT + (16 * wave + fr) * HK_STR + 4 * fq);
                  const b16x8 va = {v4[0], v4[1], v4[2], v4[3], (__bf16)0.f, (__bf16)0.f, (__bf16)0.f, (__bf16)0.f};
                  u32x4 pw; pw.x = pkb(at[0], at[1]); pw.y = pkb(at[2], at[3]); pw.z = 0u; pw.w = 0u;
                  ot = __builtin_amdgcn_mfma_f32_16x16x32_bf16(va, __builtin_bit_cast(b16x8, pw), ot, 0, 0, 0); }
#pragma unroll
                for (int ks = 0; ks < 4; ++ks) { u32x4 sw; sw.x = pkb(S[2 * ks][0], S[2 * ks][1]); sw.y = pkb(S[2 * ks][2], S[2 * ks][3]); sw.z = pkb(S[2 * ks + 1][0], S[2 * ks + 1][1]); sw.w = pkb(S[2 * ks + 1][2], S[2 * ks + 1][3]);
                    const b16x4 q0 = *(const LAS b16x4*)(QT + fr * HQ_STR + 32 * ks + 4 * fq), q1 = *(const LAS b16x4*)(QT + fr * HQ_STR + 32 * ks + 16 + 4 * fq);
                    const b16x8 qb = {q0[0], q0[1], q0[2], q0[3], q1[0], q1[1], q1[2], q1[3]};
                    ot = __builtin_amdgcn_mfma_f32_16x16x32_bf16(__builtin_bit_cast(b16x8, sw), qb, ot, 0, 0, 0); }
            }
            { b16x8 vb;
              if (fq < 2) vb = *(const LAS b16x8*)(VT + (16 * wave + fr) * HK_STR + 8 * fq); else vb = (b16x8){0, 0, 0, 0, 0, 0, 0, 0};
#pragma unroll
              for (int db = 0; db < 8; ++db) { const f32x4 dv = *(const LAS f32x4*)(DEC + 16 * db + 4 * fq);
                  b16x8 ka; if (fq < 2) ka = *(const LAS b16x8*)(KH + (16 * db + fr) * HK_STR + 8 * fq); else ka = (b16x8){0, 0, 0, 0, 0, 0, 0, 0};
                  S[db] = __builtin_amdgcn_mfma_f32_16x16x32_bf16(ka, vb, S[db] * dv, 0, 0, 0); } }
            if (OUT) {
                float ss = (ot[0] * ot[0] + ot[1] * ot[1]) + (ot[2] * ot[2] + ot[3] * ot[3]);
                ss = col_sum(ss);
                if (fq == 0) RED[wave * 16 + fr] = ss;
                __syncthreads();
                float tots = 0.f;
#pragma unroll
                for (int w2 = 0; w2 < 8; ++w2) tots += RED[w2 * 16 + fr];
                const float rstd = rsqrtf(tots * (1.f / 128.f) + NORM_EPS);
                const size_t orow = row0 + 16 * step + fr; const int ecol = 16 * wave + 4 * fq;
                const f32x4 gn = *(const GAS f32x4*)(hg_norm + ecol);
                const h16x4 gh = *(const GAS h16x4*)((const h16*)(ws + WS_Y) + orow * DM + h * 128 + ecol);
                u32x2 w; w.x = pkh(ot[0] * rstd * gn[0] * (float)gh[0], ot[1] * rstd * gn[1] * (float)gh[1]); w.y = pkh(ot[2] * rstd * gn[2] * (float)gh[2], ot[3] * rstd * gn[3] * (float)gh[3]);
                *(GAS u32x2*)((h16*)(ws + WS_H) + orow * DM + h * 128 + ecol) = w;
            }
        }
        if (!OUT) {
#pragma unroll
            for (int db = 0; db < 8; ++db)
#pragma unroll
                for (int k = 0; k < 4; ++k) ST[(size_t)u * 16384 + (size_t)(16 * db + 4 * fq + k) * 128 + 16 * wave + fr] = S[db][k];
            if (part == 0) DT[(size_t)u * 128 + d] = __expf(dsum);
        }
        __syncthreads();
    }
}

struct Args { Ptrs p; int ph_lo, ph_hi; };
constexpr int N_PHASES = 1 + 4 * 13;
#define NOINL __device__ __forceinline__
typedef const pg8::bf16_t* cbp;
NOINL void site_ffn_in(LAS unsigned char* lds, unsigned char* ws, int widx, int G, int bx, int tid) { asm volatile("" : "+s"(ws));
    pg8::Gemm g{(cbp)(ws + WS_H), (cbp)(ws + WS_W + W_FI + (size_t)widx * W_FI_SZ), T, 2 * DFF, DM, tid}; pg8::StaticOrder S; S.init(T, 2 * DFF, G, bx);
    EpiSwiglu E{(h16*)(ws + WS_X + X_ACT)}; pg8::gemm_phase<EpiSwiglu, pg8::StaticOrder, true, true>(lds, g, S, E); }
NOINL void site_ffn_out(LAS unsigned char* lds, unsigned char* ws, int widx, int G, int bx, int tid) { asm volatile("" : "+s"(ws));
    pg8::Gemm g{(cbp)(ws + WS_X + X_ACT), (cbp)(ws + WS_W + W_FO + (size_t)widx * W_FO_SZ), T, DM, DFF, tid}; pg8::StaticOrder S; S.init(T, DM, G, bx);
    EpiPlain E{(h16*)(ws + WS_Y), DM}; pg8::gemm_phase<EpiPlain, pg8::StaticOrder, true, true>(lds, g, S, E); }
NOINL void site_thin(const float* xin, float* x, unsigned char* ws, const float* gpost, float alpha, const float* gpre, int G, int bx, int tid) { asm volatile("" : "+s"(ws)); asm volatile("" : "+v"(tid));
    const int vcu = (G % 8 == 0) ? (bx % 8) * (G / 8) + bx / 8 : bx;
    thin_phase(xin, x, (const h16*)(ws + WS_Y), gpost, alpha, gpre, (h16*)(ws + WS_H), vcu, G, __builtin_amdgcn_readfirstlane(tid >> 6), tid & 63); }
NOINL void site_nsa_in(LAS unsigned char* lds, unsigned char* ws, int G, int bx, int tid) { asm volatile("" : "+s"(ws));
    pg8::Gemm g{(cbp)(ws + WS_H), (cbp)(ws + WS_W + W_NI), T, NSA_NP, DM, tid}; pg8::StaticOrder S; S.init(T, NSA_NP, G, bx);
    EpiNsaIn E{ws + WS_X, (const float*)(ws + WS_ROPE_C), (const float*)(ws + WS_ROPE_S)}; pg8::gemm_phase<EpiNsaIn, pg8::StaticOrder, true, true>(lds, g, S, E); }
NOINL void site_cmp(LAS unsigned char* lds, unsigned char* ws, int G, int bx, int tid) { asm volatile("" : "+s"(ws)); asm volatile("" : "+v"(tid)); compress_phase(ws, lds, bx, G, tid); }
NOINL void site_attn(LAS unsigned char* lds, unsigned char* ws, int G, int bx, int tid) { asm volatile("" : "+s"(ws)); asm volatile("" : "+v"(tid)); attn_phase(ws, lds, bx, G, tid); }
NOINL void site_hg_in(LAS unsigned char* lds, unsigned char* ws, int G, int bx, int tid) { asm volatile("" : "+s"(ws));
    pg8::Gemm g{(cbp)(ws + WS_H), (cbp)(ws + WS_W + W_HI), T, 4096, DM, tid}; pg8::StaticOrder S; S.init(T, 4096, G, bx);
    EpiHgIn E{ws + WS_X, (h16*)(ws + WS_Y), (const float*)(ws + WS_MISC + 4096)}; pg8::gemm_phase<EpiHgIn, pg8::StaticOrder, true, true>(lds, g, S, E); }
NOINL void site_hg_a(LAS unsigned char* lds, unsigned char* ws, int G, int bx, int tid) { asm volatile("" : "+s"(ws)); asm volatile("" : "+v"(tid)); hgrn_phase<false>(ws, nullptr, lds, bx, G, tid); }
NOINL void site_hg_b(LAS unsigned char* lds, unsigned char* ws, const float* hg_norm, int G, int bx, int tid) { asm volatile("" : "+s"(ws)); asm volatile("" : "+v"(tid)); hgrn_phase<true>(ws, hg_norm, lds, bx, G, tid); }
NOINL void site_mix_out(LAS unsigned char* lds, unsigned char* ws, size_t woff, int G, int bx, int tid) { asm volatile("" : "+s"(ws));
    pg8::Gemm g{(cbp)(ws + WS_H), (cbp)(ws + WS_W + woff), T, DM, DM, tid}; pg8::StaticOrder S; S.init(T, DM, G, bx);
    EpiPlain E{(h16*)(ws + WS_Y), DM}; pg8::gemm_phase<EpiPlain, pg8::StaticOrder, true, true>(lds, g, S, E); }
NOINL void site_ple_pe(LAS unsigned char* lds, unsigned char* ws, int l, int G, int bx, int tid) { asm volatile("" : "+s"(ws));
    int kk = PLED; asm volatile("" : "+s"(kk));
    pg8::Gemm g{(cbp)(ws + WS_PH + (size_t)l * T * PLED * 2), (cbp)(ws + WS_W + W_PI + (size_t)l * W_PI_SZ), T, DM, kk, tid}; pg8::StaticOrder S; S.init(T, DM, G, bx);
    EpiPlain E{(h16*)(ws + WS_X + X_PE), DM}; pg8::gemm_phase<EpiPlain, pg8::StaticOrder, true, true>(lds, g, S, E); }
NOINL void site_ple_gate(LAS unsigned char* lds, unsigned char* ws, int l, int G, int bx, int tid) { asm volatile("" : "+s"(ws));
    pg8::Gemm g{(cbp)(ws + WS_H), (cbp)(ws + WS_W + W_PG + (size_t)l * W_SQ_SZ), T, DM, DM, tid}; pg8::StaticOrder S; S.init(T, DM, G, bx);
    EpiPleGate E{(const h16*)(ws + WS_X + X_PE), (h16*)(ws + WS_Y)}; pg8::gemm_phase<EpiPleGate, pg8::StaticOrder, true, true>(lds, g, S, E); }

DI int lane_id_now() { int x; asm volatile("v_mbcnt_lo_u32_b32 %0, -1, 0\n\tv_mbcnt_hi_u32_b32 %0, -1, %0" : "=v"(x)); return x; }
__global__ void __launch_bounds__(NTHREADS, 2) fwd_kernel(Args args) {
    extern __shared__ __attribute__((aligned(16))) unsigned char lds_raw[];
    LAS unsigned char* lds = (LAS unsigned char*)lds_raw;
    const int wave_s = __builtin_amdgcn_readfirstlane((int)threadIdx.x >> 6);
#define tid ((wave_s << 6) | lane_id_now())
    const int G = gridDim.x, bx = blockIdx.x;
    if ((int)threadIdx.x < 32) ((LAS unsigned*)(lds + LDSCTL_OFF))[threadIdx.x] = 0u;
    __syncthreads();
    unsigned char* ws = args.p.ws;
    XcdBarrier bar = xcd_barrier_post((unsigned*)(ws + WS_CTL) + CW_BAR, (volatile LAS unsigned*)(lds + LDSCTL_OFF));
    const int lo = args.ph_lo, hi = args.ph_hi;
    int ph = 0;
#ifndef ENMASK
#define ENMASK 0xFFFF
#endif
#define EN(j) ((ENMASK >> (j)) & 1)
#define RUN(k) ((k) >= lo && (k) < hi)
#define SEAM(k) do { if (RUN(k) && RUN((k) + 1)) xcd_barrier(bar); } while (0)
    PROF_BEGIN(99);
    if (EN(0) && RUN(0)) { const int vcu = (G % 8 == 0) ? (bx % 8) * (G / 8) + bx / 8 : bx; p0_prologue(args.p, lds, vcu, G, __builtin_amdgcn_readfirstlane(tid >> 6), tid & 63); }
    PROF_END(99);
    SEAM(0);
#pragma unroll 1
    for (int hs = 0; hs < 2 * DEPTH; ++hs) {
        const int l = hs >> 1, second = hs & 1, base = 1 + hs * 13;
        const float* ng = args.p.ng + (size_t)l * 8 * DM;
        ph = base + 0; PROF_BEGIN(100); if (EN(1) && RUN(ph)) { site_ffn_in(lds, ws, 2 * l + second, G, bx, tid);
#ifdef DUP_FFNIN
 __syncthreads(); site_ffn_in(lds, ws, 2 * l + second, G, bx, tid);
#endif
 } PROF_END(ph - base + 100); SEAM(ph);
        ph = base + 1; PROF_BEGIN(101); if (EN(2) && RUN(ph)) site_ffn_out(lds, ws, 2 * l + second, G, bx, tid); PROF_END(ph - base + 100); SEAM(ph);
        ph = base + 2; PROF_BEGIN(102); if (EN(3) && RUN(ph)) site_thin(hs == 0 ? args.p.x : args.p.out, args.p.out, ws, ng + (second ? 5 : 1) * DM, 0.5f, ng + (second ? 6 : 2) * DM, G, bx, tid); PROF_END(ph - base + 100); SEAM(ph);
        if (!second) {
            if (l == 0) {
                ph = base + 3; PROF_BEGIN(103); if (EN(4) && RUN(ph)) site_nsa_in(lds, ws, G, bx, tid); PROF_END(ph - base + 100); SEAM(ph);
                ph = base + 4; PROF_BEGIN(104); if (EN(5) && RUN(ph)) { site_cmp(lds, ws, G, bx, tid);
#ifdef DUP_CMP
 __syncthreads(); site_cmp(lds, ws, G, bx, tid);
#endif
 } PROF_END(ph - base + 100); SEAM(ph);
                ph = base + 5; PROF_BEGIN(105); if (EN(6) && RUN(ph)) { site_attn(lds, ws, G, bx, tid);
#ifdef DUP_ATT
 __syncthreads(); site_attn(lds, ws, G, bx, tid);
#endif
 } PROF_END(ph - base + 100); SEAM(ph);
            } else {
                ph = base + 6; PROF_BEGIN(106); if (EN(7) && RUN(ph)) site_hg_in(lds, ws, G, bx, tid); PROF_END(ph - base + 100); SEAM(ph);
                ph = base + 7; PROF_BEGIN(107); if (EN(8) && RUN(ph)) { site_hg_a(lds, ws, G, bx, tid);
#ifdef DUP_HGA
 __syncthreads(); site_hg_a(lds, ws, G, bx, tid);
#endif
 } PROF_END(ph - base + 100); SEAM(ph);
                ph = base + 8; PROF_BEGIN(108); if (EN(9) && RUN(ph)) { site_hg_b(lds, ws, args.p.hg_norm, G, bx, tid);
#ifdef DUP_HGB
 __syncthreads(); site_hg_b(lds, ws, args.p.hg_norm, G, bx, tid);
#endif
 } PROF_END(ph - base + 100); SEAM(ph);
            }
            ph = base + 9; PROF_BEGIN(109); if (EN(10) && RUN(ph)) site_mix_out(lds, ws, l == 0 ? W_NO : W_HO, G, bx, tid); PROF_END(ph - base + 100); SEAM(ph);
            ph = base + 10; PROF_BEGIN(110); if (EN(11) && RUN(ph)) site_thin(args.p.out, args.p.out, ws, ng + 3 * DM, 1.0f, ng + 4 * DM, G, bx, tid); PROF_END(ph - base + 100); SEAM(ph);
        } else {
            ph = base + 11; PROF_BEGIN(111); if (EN(12) && RUN(ph)) {
#ifndef NO_PE
 site_ple_pe(lds, ws, l, G, bx, tid);
#endif
 asm volatile("s_waitcnt vmcnt(0)" ::: "memory"); __syncthreads();
#ifndef NO_GATE
 site_ple_gate(lds, ws, l, G, bx, tid);
#endif
 } PROF_END(ph - base + 100); SEAM(ph);
            ph = base + 12; PROF_BEGIN(112); if (EN(13) && RUN(ph)) site_thin(args.p.out, args.p.out, ws, ng + 7 * DM, 1.0f, (l + 1 < DEPTH) ? args.p.ng + (size_t)(l + 1) * 8 * DM : nullptr, G, bx, tid); PROF_END(ph - base + 100); SEAM(ph);
        }
    }
#ifdef PROF
    xcd_barrier(bar);
    if (threadIdx.x == 0) { const float tt = (float)*(LAS unsigned long long*)(lds + PROF_ACC);
#ifdef PROF_MIN
        args.p.out[bx] += 200000.0f / fmaxf(tt, 1.f);
#else
        args.p.out[bx] += tt * (1.0f / 20000.0f);
#endif
    }
#endif
#undef RUN
#undef SEAM
#undef tid
}

#ifndef MK_PER_PHASE
#define MK_PER_PHASE 0
#endif
extern "C" void kernel_launch(void* const* d_in, const int* in_sizes, int n_in, void* d_out, int out_size, void* d_ws, size_t ws_size, hipStream_t stream) {
    static int grid = 0;
    if (grid == 0) {
        if (n_in != 16 || in_sizes[0] != T * DM || out_size != T * DM || ws_size < WS_END) { fprintf(stderr, "kernel_launch: unexpected shapes / workspace (%d inputs, ws %zu)\n", n_in, ws_size); grid = -1; return; }
        int dev = 0, cus = 0, per_cu = 0;
        if (hipGetDevice(&dev) != hipSuccess || hipDeviceGetAttribute(&cus, hipDeviceAttributeMultiprocessorCount, dev) != hipSuccess) { grid = -1; return; }
        if (hipFuncSetAttribute((const void*)fwd_kernel, hipFuncAttributeMaxDynamicSharedMemorySize, LDS_BYTES) != hipSuccess) { grid = -1; return; }
        if (hipOccupancyMaxActiveBlocksPerMultiprocessor(&per_cu, (const void*)fwd_kernel, NTHREADS, LDS_BYTES) != hipSuccess || per_cu < 1) { fprintf(stderr, "kernel_launch: occupancy query says %d\n", per_cu); }
        (void)hipGetLastError();
        grid = cus;
    }
    if (grid < 0) return;
    if (hipMemsetAsync((char*)d_ws + WS_CTL, 0, CTL_ZERO_BYTES, stream) != hipSuccess) return;
    Args a{};
    const float* const* in = (const float* const*)d_in;
    a.p.x = in[0]; a.p.p = in[1]; a.p.ng = in[2]; a.p.ffn_in = in[3]; a.p.ffn_out = in[4]; a.p.ple_in = in[5]; a.p.ple_gate = in[6]; a.p.nsa_in = in[7]; a.p.nsa_out = in[8];
    a.p.cmp_pos = in[9]; a.p.cmp_w1 = in[10]; a.p.cmp_w2 = in[11]; a.p.hg_in = in[12]; a.p.hg_out = in[13]; a.p.hg_norm = in[14]; a.p.hg_lb = in[15];
    a.p.out = (float*)d_out; a.p.ws = (unsigned char*)d_ws;
#if MK_PER_PHASE
    for (int k = 0; k < N_PHASES; ++k) { a.ph_lo = k; a.ph_hi = k + 1; hipLaunchKernelGGL(fwd_kernel, dim3(grid), dim3(NTHREADS), LDS_BYTES, stream, a); }
#else
    a.ph_lo = 0; a.ph_hi = N_PHASES;
    hipLaunchKernelGGL(fwd_kernel, dim3(grid), dim3(NTHREADS), LDS_BYTES, stream, a);
#endif
}
```

```cpp
#include <hip/hip_runtime.h>
#include <cstdio>
#include <cstdint>
#include <cmath>
namespace pg8 {
#define PG8_LAS __attribute__((address_space(3)))
typedef unsigned short bf16_t;
typedef _Float16 bf16x8 __attribute__((ext_vector_type(8)));
typedef float f32x4 __attribute__((ext_vector_type(4)));
typedef unsigned u32x4 __attribute__((ext_vector_type(4)));
constexpr int BM = 256, BK = 64, HALF = 128, HTB = HALF * BK * 2  , STAGE_BYTES = 8 * HTB, NXCD = 8, WGM = 8;

__host__ __device__ __forceinline__ int lds_byte(int r, int c) { const int st = (r >> 4) * 2 + (c >> 5), rr = r & 15, cc = c & 31, ob = rr * 64 + cc * 2; return st * 1024 + (ob ^ (((ob >> 9) & 1) << 5)); }
__host__ __device__ __forceinline__ void stage_rc(int b, int& R, int& C) { const int st = b / 1024, sb = b % 1024, swz = sb ^ (((sb >> 9) & 1) << 5); R = (st >> 1) * 16 + swz / 64; C = (st & 1) * 32 + (swz % 64) / 2; }
__host__ __device__ __forceinline__ int perm32(int rho) { const int n = rho >> 4, i = rho & 15; return 8 * (i >> 2) + 4 * n + (i & 3); }

struct Unit { int pm, pn; };
struct Gemm { const bf16_t* A; const bf16_t* Bt; int M, N, K; int tid; };

struct StaticOrder {
    int nM, nN, nwg, G, c;
    __host__ __device__ void init(int M, int N, int G_, int c_) { nM = M / BM; nN = N / BM; nwg = nM * nN; G = G_; c = c_; }
    __host__ __device__ bool next(int i, Unit& u) const {
        const long L = (long)i * G + c; if (L >= nwg) return false;
        int wgid = (int)L; { const int q = nwg / NXCD, r = nwg % NXCD, xcd = wgid % NXCD, off = wgid / NXCD; wgid = (xcd < r ? xcd * (q + 1) : r * (q + 1) + (xcd - r) * q) + off; }
        const int nig = WGM * nN, gid = wgid / nig, fm = gid * WGM, gsz = (nM - fm) < WGM ? (nM - fm) : WGM;
        u.pm = fm + ((wgid % nig) % gsz); u.pn = (wgid % nig) / gsz; return true;
    }
    __device__ __forceinline__ void a_ready(const Unit&) const {}
    __device__ __forceinline__ void done(const Unit&) const {}
};

template <class Epi, class Sched, bool ALIGN_EPI = false, bool SP2 = false>
__device__ __forceinline__ void gemm_phase(PG8_LAS unsigned char* lds, const Gemm g, const Sched& S, const Epi& E) {
    int tid_l = g.tid; asm volatile("" : "+v"(tid_l));
    const int tid = tid_l, wid = __builtin_amdgcn_readfirstlane(tid >> 6), lane = tid & 63, wr = wid >> 2, wc = wid & 3, fr = lane & 15, fq = lane >> 4;
    const int K = g.K, nt = K / BK;
    unsigned voffA[2], voffB[2];
#pragma unroll
    for (int i = 0; i < 2; ++i) { int R, C; stage_rc(tid * 16 + i * 8192, R, C); const int Rb = Epi::PERM ? ((R & ~31) + perm32(R & 31)) : R;
        voffA[i] = (unsigned)(R * K + C) * 2u; voffB[i] = (unsigned)(Rb * K + C) * 2u; }
    const size_t kstep = (size_t)(BK * 2);
    const size_t hstep = (size_t)HALF * K * 2;
    const size_t tstep = 2 * hstep;
    const unsigned ldsw = (unsigned)wid * 1024u;
    const int aoff = lds_byte(wr * 64 + fr, fq * 8), boff = lds_byte(wc * 32 + fr, fq * 8);
#define PG8_SA(b, h) (((b) * 2 + (h)) * HTB)
#define PG8_SB(b, h) ((4 + (b) * 2 + (h)) * HTB)
#define PG8_STAGE(bufoff, gbase, voff) do { _Pragma("unroll") for (int _i = 0; _i < 2; ++_i) \
        __builtin_amdgcn_global_load_lds((const unsigned*)((const char*)(gbase) + (voff)[_i]), (PG8_LAS unsigned*)(lds + (bufoff) + ldsw + _i * 8192), 16, 0, 0); } while (0)
#define PG8_LDA(dst, b, h) do { _Pragma("unroll") for (int m = 0; m < 4; ++m) _Pragma("unroll") for (int k = 0; k < 2; ++k) dst[m][k] = *(const PG8_LAS bf16x8*)(lds + PG8_SA(b, h) + aoff + m * 2048 + k * 1024); } while (0)
#define PG8_LDB(dst, b, h) do { _Pragma("unroll") for (int n = 0; n < 2; ++n) _Pragma("unroll") for (int k = 0; k < 2; ++k) dst[n][k] = *(const PG8_LAS bf16x8*)(lds + PG8_SB(b, h) + boff + n * 2048 + k * 1024); } while (0)
#define PG8_MMA(ai, bj, At, Bt) do { __builtin_amdgcn_s_setprio(1); _Pragma("unroll") for (int m = 0; m < 4; ++m) _Pragma("unroll") for (int n = 0; n < 2; ++n) _Pragma("unroll") for (int k = 0; k < 2; ++k) \
        acc[ai][bj][m][n] = __builtin_amdgcn_mfma_f32_16x16x32_f16(Bt[n][k], At[m][k], acc[ai][bj][m][n], 0, 0, 0); __builtin_amdgcn_s_setprio(0); } while (0)
#define PG8_WAIT_V(n) asm volatile("s_waitcnt vmcnt(" #n ")" ::: "memory")
#define PG8_WAIT_L(n) asm volatile("s_waitcnt lgkmcnt(" #n ")" ::: "memory")
#define PG8_BAR __builtin_amdgcn_s_barrier()
#define PG8_SCHED __builtin_amdgcn_sched_barrier(0)
    Unit cur, nxt; int ui = 0;
    if (!S.next(0, cur)) return;
    f32x4 acc[2][2][4][2];
#pragma unroll
    for (int a = 0; a < 2; ++a)
#pragma unroll
        for (int b = 0; b < 2; ++b)
#pragma unroll
            for (int m = 0; m < 4; ++m)
#pragma unroll
                for (int n = 0; n < 2; ++n) acc[a][b][m][n] = (f32x4){0.f, 0.f, 0.f, 0.f};
    bf16x8 At[4][2], B0[2][2], B1[2][2];
    const char* cA = (const char*)g.A + (size_t)cur.pm * tstep; const char* cB = (const char*)g.Bt + (size_t)cur.pn * tstep;
    S.a_ready(cur);
    if constexpr (SP2) {
        PG8_STAGE(PG8_SB(0, 0), cB, voffB); PG8_STAGE(PG8_SB(0, 1), cB + hstep, voffB); PG8_STAGE(PG8_SA(0, 0), cA, voffA); PG8_STAGE(PG8_SA(0, 1), cA + hstep, voffA);
        if (wr == 1) PG8_BAR;
        PG8_WAIT_V(2); PG8_BAR;
        PG8_STAGE(PG8_SB(1, 0), cB + kstep, voffB); PG8_STAGE(PG8_SA(1, 0), cA + kstep, voffA); PG8_STAGE(PG8_SB(1, 1), cB + hstep + kstep, voffB);
        PG8_WAIT_V(6); PG8_BAR;
    } else {
        PG8_STAGE(PG8_SB(0, 0), cB, voffB); PG8_STAGE(PG8_SA(0, 0), cA, voffA); PG8_STAGE(PG8_SB(0, 1), cB + hstep, voffB); PG8_STAGE(PG8_SA(0, 1), cA + hstep, voffA);
        if (wr == 1) PG8_BAR;
        PG8_WAIT_V(4); PG8_BAR;
        PG8_STAGE(PG8_SB(1, 0), cB + kstep, voffB); PG8_STAGE(PG8_SA(1, 0), cA + kstep, voffA); PG8_STAGE(PG8_SB(1, 1), cB + hstep + kstep, voffB);
        PG8_WAIT_V(6); PG8_BAR;
    }
    for (;;) {
        const bool has_next = S.next(ui + 1, nxt);
        const char* nA = has_next ? (const char*)g.A + (size_t)nxt.pm * tstep : cA; const char* nB = has_next ? (const char*)g.Bt + (size_t)nxt.pn * tstep : cB;
        for (int t = 0; t < nt; t += 2) {
            const bool last = (t == nt - 2);
            const char* a1 = cA + (size_t)(t + 1) * kstep;
            const char* a2 = last ? nA : cA + (size_t)(t + 2) * kstep; const char* b2 = last ? nB : cB + (size_t)(t + 2) * kstep;
            const char* a3 = a2 + kstep; const char* b3 = b2 + kstep;
            if (last && has_next) S.a_ready(nxt);
            if constexpr (SP2) {
            PG8_LDB(B0, 0, 0); PG8_LDB(B1, 0, 1); PG8_SCHED; PG8_LDA(At, 0, 0); PG8_STAGE(PG8_SA(1, 1), a1 + hstep, voffA);
            PG8_WAIT_V(8); PG8_WAIT_L(0); PG8_BAR; PG8_MMA(0, 0, At, B0); PG8_MMA(0, 1, At, B1); PG8_BAR; PG8_SCHED;
            PG8_LDA(At, 0, 1); PG8_STAGE(PG8_SB(0, 0), b2, voffB); PG8_STAGE(PG8_SB(0, 1), b2 + hstep, voffB); PG8_STAGE(PG8_SA(0, 0), a2, voffA);
            PG8_WAIT_V(8); PG8_WAIT_L(0); PG8_BAR; PG8_MMA(1, 0, At, B0); PG8_MMA(1, 1, At, B1); PG8_BAR; PG8_SCHED;
            PG8_LDB(B0, 1, 0); PG8_LDB(B1, 1, 1); PG8_SCHED; PG8_LDA(At, 1, 0); PG8_STAGE(PG8_SA(0, 1), a2 + hstep, voffA);
            PG8_WAIT_V(8); PG8_WAIT_L(0); PG8_BAR; PG8_MMA(0, 0, At, B0); PG8_MMA(0, 1, At, B1); PG8_BAR; PG8_SCHED;
            PG8_LDA(At, 1, 1); PG8_STAGE(PG8_SB(1, 0), b3, voffB); PG8_STAGE(PG8_SB(1, 1), b3 + hstep, voffB); PG8_STAGE(PG8_SA(1, 0), a3, voffA);
            PG8_WAIT_V(8); PG8_WAIT_L(0); PG8_BAR; PG8_MMA(1, 0, At, B0); PG8_MMA(1, 1, At, B1); PG8_BAR; PG8_SCHED;
            } else {
            PG8_LDB(B0, 0, 0); PG8_SCHED; PG8_LDA(At, 0, 0); PG8_STAGE(PG8_SA(1, 1), a1 + hstep, voffA);
            PG8_WAIT_L(8); PG8_BAR; PG8_WAIT_L(0); PG8_MMA(0, 0, At, B0); PG8_BAR; PG8_SCHED;
            PG8_LDB(B1, 0, 1); PG8_STAGE(PG8_SB(0, 0), b2, voffB);
            PG8_BAR; PG8_WAIT_L(0); PG8_MMA(0, 1, At, B1); PG8_BAR;
            PG8_LDA(At, 0, 1); PG8_STAGE(PG8_SA(0, 0), a2, voffA);
            PG8_BAR; PG8_WAIT_L(0); PG8_MMA(1, 0, At, B0); PG8_BAR; PG8_SCHED;
            PG8_STAGE(PG8_SB(0, 1), b2 + hstep, voffB);
            PG8_WAIT_V(6); PG8_BAR; PG8_MMA(1, 1, At, B1); PG8_BAR;
            PG8_LDB(B0, 1, 0); PG8_SCHED; PG8_LDA(At, 1, 0); PG8_STAGE(PG8_SA(0, 1), a2 + hstep, voffA);
            PG8_WAIT_L(8); PG8_BAR; PG8_WAIT_L(0); PG8_MMA(0, 0, At, B0); PG8_BAR; PG8_SCHED;
            PG8_LDB(B1, 1, 1); PG8_STAGE(PG8_SB(1, 0), b3, voffB);
            PG8_BAR; PG8_WAIT_L(0); PG8_MMA(0, 1, At, B1); PG8_BAR;
            PG8_LDA(At, 1, 1); PG8_STAGE(PG8_SA(1, 0), a3, voffA);
            PG8_BAR; PG8_WAIT_L(0); PG8_MMA(1, 0, At, B0); PG8_BAR; PG8_SCHED;
            PG8_STAGE(PG8_SB(1, 1), b3 + hstep, voffB);
            PG8_WAIT_V(6); PG8_BAR; PG8_MMA(1, 1, At, B1); PG8_BAR;
            }
        }
        if constexpr (ALIGN_EPI) { if (wr == 0) PG8_BAR; }
        if constexpr (!Epi::AFTER_DRAIN) { E(acc, cur, wr, wc, fr, fq); S.done(cur); }
        if (!has_next) break;
#pragma unroll
        for (int a = 0; a < 2; ++a)
#pragma unroll
            for (int b = 0; b < 2; ++b)
#pragma unroll
                for (int m = 0; m < 4; ++m)
#pragma unroll
                    for (int n = 0; n < 2; ++n) acc[a][b][m][n] = (f32x4){0.f, 0.f, 0.f, 0.f};
        cur = nxt; cA = nA; cB = nB; ++ui;
        if constexpr (ALIGN_EPI) { if (wr == 1) PG8_BAR; }
    }
    PG8_WAIT_V(0);
    if constexpr (!ALIGN_EPI) { if (wr == 0) PG8_BAR; }
    PG8_BAR;
    if constexpr (Epi::AFTER_DRAIN) { E.fused(acc, cur, wr, wc, fr, fq, lds, wid, lane); S.done(cur); }
#undef PG8_SA
#undef PG8_SB
#undef PG8_STAGE
#undef PG8_LDA
#undef PG8_LDB
#undef PG8_MMA
#undef PG8_WAIT_V
#undef PG8_WAIT_L
#undef PG8_BAR
#undef PG8_SCHED
}
}

#define GAS __attribute__((address_space(1)))
#define LAS __attribute__((address_space(3)))
#define XB_TMO      128
#define XB_XCNT(j)  (256  + 64 * (j))
#define XB_XSUB(j)  (1280 + 64 * (j))
#define XB_XGEN(j)  (2304 + 64 * (j))
#define XB_TOP      3328
#define XB_TOPGEN   3392
#define XCD_BAR_WORDS 3456
#define XB_SPIN_CAP (1u << 18)

__device__ __forceinline__ unsigned xb_ld(unsigned* p)              { return __hip_atomic_load(p, __ATOMIC_RELAXED, __HIP_MEMORY_SCOPE_AGENT); }
__device__ __forceinline__ unsigned xb_add(unsigned* p, unsigned v) { return __hip_atomic_fetch_add(p, v, __ATOMIC_RELAXED, __HIP_MEMORY_SCOPE_AGENT); }
__device__ __forceinline__ unsigned xb_xcc_id() { return (unsigned)__builtin_amdgcn_s_getreg((3 << 11) | 20) & 0xFu; }
#define XB_SPIN(cond, bar) do { unsigned _sp = 0; while (cond) { __builtin_amdgcn_s_sleep(1); \
    if ((++_sp & 255u) == 0u) { if (xb_ld(&(bar)[XB_TMO])) break; if (_sp > XB_SPIN_CAP) { atomicAdd(&(bar)[XB_TMO], 1u); break; } } } } while (0)

struct XcdBarrier {
    unsigned* bar; unsigned x;
    volatile LAS unsigned* st;
};

__device__ __forceinline__ XcdBarrier xcd_barrier_post(unsigned* bar, volatile LAS unsigned* st) {
    XcdBarrier b; b.bar = bar; b.x = xb_xcc_id(); b.st = st;
    if (threadIdx.x == 0) (void)xb_add(&bar[XB_XCNT(b.x)], 1u);
    return b;
}
__device__ __forceinline__ void xcd_barrier_complete(unsigned* bar, unsigned x, unsigned& nloc, unsigned& nx) {
    const unsigned G = gridDim.x * gridDim.y * gridDim.z;
    unsigned sum, cnt, mine, sp = 0u;
    for (;;) {
        sum = 0u; cnt = 0u; mine = 0u;
#pragma unroll
        for (unsigned j = 0; j < 16; ++j) { const unsigned c = xb_ld(&bar[XB_XCNT(j)]); sum += c; cnt += (c > 0u) ? 1u : 0u; mine = (j == x) ? c : mine; }
        if (sum == G) break;
        __builtin_amdgcn_s_sleep(1);
        if ((++sp & 255u) == 0u) { if (xb_ld(&bar[XB_TMO])) break; if (sp > XB_SPIN_CAP) { atomicAdd(&bar[XB_TMO], 1u); break; } }
    }
    nloc = mine > 0u ? mine : 1u; nx = cnt > 0u ? cnt : 1u;
}

__device__ __forceinline__ void xcd_barrier(const XcdBarrier& b) {
    asm volatile("s_waitcnt vmcnt(0)" ::: "memory");
    __syncthreads();
    if (threadIdx.x == 0) {
        unsigned* bar = b.bar;
        __builtin_amdgcn_s_waitcnt(0);
        unsigned nloc = b.st[0], nx = b.st[1];
        if (nloc == 0u) { xcd_barrier_complete(bar, b.x, nloc, nx); b.st[0] = nloc; b.st[1] = nx; }
        const unsigned old = xb_add(&bar[XB_XSUB(b.x)], 1u);
        const unsigned gen = old / nloc;
        if (old + 1u == (gen + 1u) * nloc) {
            __builtin_amdgcn_fence(__ATOMIC_RELEASE, "agent");
            asm volatile("s_waitcnt vmcnt(0)" ::: "memory");
            const unsigned og = xb_add(&bar[XB_TOP], 1u);
            const unsigned tg = og / nx;
            if (og + 1u == (tg + 1u) * nx) xb_add(&bar[XB_TOPGEN], 1u);
            else XB_SPIN(xb_ld(&bar[XB_TOPGEN]) == tg, bar);
            __builtin_amdgcn_fence(__ATOMIC_ACQUIRE, "agent");
            xb_add(&bar[XB_XGEN(b.x)], 1u);
            asm volatile("s_waitcnt vmcnt(0)" ::: "memory");
        } else {
            XB_SPIN(xb_ld(&bar[XB_XGEN(b.x)]) == gen, bar);
            __builtin_amdgcn_fence(__ATOMIC_ACQUIRE, "agent");
            asm volatile("s_waitcnt vmcnt(0)" ::: "memory");
        }
    }
    __syncthreads();
}


constexpr int BATCH = 2, SEQ = 16384, DM = 1024, T = BATCH * SEQ, DFF = 2816, PLED = 256, DEPTH = 2;
constexpr int NH = 16, NG = 4, HD = 64, NSA_IN = 2608, NSA_NP = 2816;
constexpr int NCMP = 1023, NCMP_P = 1024;
constexpr int HG_H = 8, HG_D = 128;
constexpr float NORM_EPS = 1e-6f;
constexpr float LOG2E = 1.4426950408889634f;
constexpr int NWAVES = 8, NTHREADS = 512;

constexpr size_t MiB = 1u << 20;
constexpr size_t WS_CTL = 0, CTL_ZERO_BYTES = 1 * MiB;
constexpr size_t WS_ROPE_C = 1 * MiB, WS_ROPE_S = 3 * MiB;
constexpr size_t WS_MISC = 5 * MiB;
constexpr size_t WS_W = 6 * MiB;
constexpr size_t W_FI = 0;
constexpr size_t W_FI_SZ = (size_t)2 * DFF * DM * 2;
constexpr size_t W_FO = W_FI + 4 * W_FI_SZ;
constexpr size_t W_FO_SZ = (size_t)DM * DFF * 2;
constexpr size_t W_PI = W_FO + 4 * W_FO_SZ;
constexpr size_t W_PI_SZ = (size_t)DM * PLED * 2;
constexpr size_t W_PG = W_PI + 2 * W_PI_SZ;
constexpr size_t W_SQ_SZ = (size_t)DM * DM * 2;
constexpr size_t W_NI = W_PG + 2 * W_SQ_SZ;
constexpr size_t W_NI_SZ = (size_t)NSA_NP * DM * 2;
constexpr size_t W_NO = W_NI + W_NI_SZ;
constexpr size_t W_HI = W_NO + W_SQ_SZ;
constexpr size_t W_HI_SZ = (size_t)4096 * DM * 2;
constexpr size_t W_HO = W_HI + W_HI_SZ;
constexpr size_t W_C1 = W_HO + W_SQ_SZ;
constexpr size_t W_C1_SZ = (size_t)64 * 2048 * 2;
constexpr size_t W_C2 = W_C1 + 2 * W_C1_SZ;
constexpr size_t W_C2_SZ = (size_t)64 * 64 * 2;
constexpr size_t W_END = W_C2 + 2 * W_C2_SZ;
static_assert(W_END <= 96 * MiB, "weights region");
constexpr size_t WS_PH = 102 * MiB;
constexpr size_t WS_H = 134 * MiB;
constexpr size_t WS_Y = 198 * MiB;
constexpr size_t WS_X = 262 * MiB;
constexpr size_t X_ACT = 0;
constexpr size_t X_Q = 0, X_KC = 64 * MiB, X_VC = 80 * MiB, X_KS = 96 * MiB, X_VS = 112 * MiB, X_KW = 128 * MiB, X_VW = 144 * MiB;
constexpr size_t X_GATES = 160 * MiB, X_KCMP = 168 * MiB, X_VCMP = 169 * MiB, X_OSCR = 170 * MiB;
constexpr size_t X_QH = 0, X_LF = 64 * MiB, X_VH = 128 * MiB, X_ST = 192 * MiB, X_DT = 208 * MiB;
constexpr size_t X_PE = 0;
constexpr size_t WS_END = 471 * MiB;
constexpr int CW_BAR = 4096, CW_SS = 32768, CW_KMAX = 2048;

constexpr int RING_BYTES = 131072;
constexpr int LDSCTL_OFF = RING_BYTES;
constexpr int LDS_BYTES = 147456;

#ifdef PROF
#define PROF_T0 (LDSCTL_OFF + 64)
#define PROF_ACC (LDSCTL_OFF + 72)
#define PROF_BEGIN(id) do { if ((id) == PROF && threadIdx.x == 0) *(LAS unsigned long long*)(lds + PROF_T0) = __builtin_amdgcn_s_memrealtime(); } while (0)
#define PROF_END(id) do { if ((id) == PROF && threadIdx.x == 0) { *(LAS unsigned long long*)(lds + PROF_ACC) += __builtin_amdgcn_s_memrealtime() - *(LAS unsigned long long*)(lds + PROF_T0); } } while (0)
#else
#define PROF_BEGIN(id) do { } while (0)
#define PROF_END(id) do { } while (0)
#endif

typedef _Float16 h16;
typedef _Float16 h16x8 __attribute__((ext_vector_type(8)));
typedef _Float16 h16x4 __attribute__((ext_vector_type(4)));
typedef _Float16 h16x2 __attribute__((ext_vector_type(2)));
typedef __bf16 b16x8 __attribute__((ext_vector_type(8)));
typedef __bf16 b16x4 __attribute__((ext_vector_type(4)));
typedef float f32x4 __attribute__((ext_vector_type(4)));
typedef float f32x2 __attribute__((ext_vector_type(2)));
typedef unsigned u32x4 __attribute__((ext_vector_type(4)));
typedef unsigned u32x2 __attribute__((ext_vector_type(2)));
typedef short s16x4 __attribute__((ext_vector_type(4)));
typedef short s16x8 __attribute__((ext_vector_type(8)));

#define DI __device__ __forceinline__
#define LDS_WAIT() asm volatile("s_waitcnt lgkmcnt(0)" ::: "memory")

DI float wave_sum(float v) {
#pragma unroll
    for (int o = 1; o < 64; o <<= 1) v += __shfl_xor(v, o);
    return v;
}
DI float sigmoidf_(float x) { return __builtin_amdgcn_rcpf(1.0f + __expf(-x)); }
DI float siluf_(float x) { return x * __builtin_amdgcn_rcpf(1.0f + __expf(-x)); }
DI unsigned pkh(float a, float b) { h16x2 v = {(h16)a, (h16)b}; return __builtin_bit_cast(unsigned, v); }
DI u32x4 pkh8(f32x4 a, f32x4 b) { u32x4 w; w.x = pkh(a[0], a[1]); w.y = pkh(a[2], a[3]); w.z = pkh(b[0], b[1]); w.w = pkh(b[2], b[3]); return w; }
DI unsigned pkb(float a, float b) { typedef __bf16 b2 __attribute__((ext_vector_type(2))); f32x2 f = {a, b}; b2 v = __builtin_convertvector(f, b2); return __builtin_bit_cast(unsigned, v); }

struct Ptrs {
    const float *x, *p, *ng, *ffn_in, *ffn_out, *ple_in, *ple_gate, *nsa_in, *nsa_out, *cmp_pos, *cmp_w1, *cmp_w2, *hg_in, *hg_out, *hg_norm, *hg_lb;
    float* out; unsigned char* ws;
};

DI void transpose_item(const float* W, int ldw, int K, h16* WT, int dstrow0, int srccol0, int nvalid, int k0, LAS float* scr, int lane) {
    const int nn = lane & 31;
#pragma unroll 8
    for (int i = 0; i < 32; ++i) { const int kk = 2 * i + (lane >> 5); scr[kk * 33 + nn] = (nn < nvalid) ? W[(size_t)(k0 + kk) * ldw + srccol0 + nn] : 0.f; }
    LDS_WAIT(); asm volatile("" ::: "memory");
    const int c = lane & 7;
#pragma unroll
    for (int j = 0; j < 4; ++j) { const int n = (lane >> 3) + 8 * j; const LAS float* s = scr + (8 * c) * 33 + n;
        u32x4 o; o.x = pkh(s[0 * 33], s[1 * 33]); o.y = pkh(s[2 * 33], s[3 * 33]); o.z = pkh(s[4 * 33], s[5 * 33]); o.w = pkh(s[6 * 33], s[7 * 33]);
        *(GAS u32x4*)(WT + (size_t)(dstrow0 + n) * K + k0 + 8 * c) = o; }
    LDS_WAIT(); asm volatile("" ::: "memory");
}
template <int MAP> DI bool conv_matrix(int& it, const float* W, int ldw, int K, int NR, h16* WT, LAS float* scr, int lane) {
    const int nrb = NR / 32, nitems = (K / 64) * nrb;
    if (it >= nitems) { it -= nitems; return false; }
    const int kb = it / nrb, rb = it % nrb, c0 = 32 * rb;
    int src = c0, nvalid = 32;
    if (MAP == 1) { const int pn = c0 >> 8, bj = (c0 >> 7) & 1, j0 = c0 & 127; src = bj * DFF + 128 * pn + j0; }
    if (MAP == 2) { const int pn = c0 >> 8, bj = (c0 >> 7) & 1, hl = (c0 & 127) >> 5;
        if (pn < 4) src = (4 * pn + hl) * 64 + 32 * bj;
        else if (pn < 10) src = 1024 + (pn - 4) * 256 + hl * 64 + 32 * bj;
        else { const int jj = c0 & 255; src = 2560 + jj; nvalid = 48 - jj; nvalid = nvalid < 0 ? 0 : (nvalid > 32 ? 32 : nvalid); if (nvalid == 0) src = 0; } }
    transpose_item(W, ldw, K, WT, c0, src, nvalid, 64 * kb, scr, lane);
    return true;
}
DI void rms_row_to_h16(const float* xrow, const float* gain, h16* orow, float* xcopy, int lane) {
    const GAS f32x4* xr = (const GAS f32x4*)xrow; const GAS f32x4* gr = (const GAS f32x4*)gain;
    f32x4 v[4]; float s = 0.f;
#pragma unroll
    for (int j = 0; j < 2; ++j) { v[2 * j] = xr[2 * lane + 128 * j]; v[2 * j + 1] = xr[2 * lane + 1 + 128 * j]; }
#pragma unroll
    for (int j = 0; j < 4; ++j) s += (v[j].x * v[j].x + v[j].y * v[j].y) + (v[j].z * v[j].z + v[j].w * v[j].w);
    const float r = rsqrtf(wave_sum(s) * (1.f / DM) + NORM_EPS);
#pragma unroll
    for (int j = 0; j < 2; ++j) {
        if (xcopy) { ((GAS f32x4*)xcopy)[2 * lane + 128 * j] = v[2 * j]; ((GAS f32x4*)xcopy)[2 * lane + 1 + 128 * j] = v[2 * j + 1]; }
        const f32x4 g0 = gr[2 * lane + 128 * j], g1 = gr[2 * lane + 1 + 128 * j];
        *(GAS u32x4*)(orow + 8 * lane + 512 * j) = pkh8(v[2 * j] * r * g0, v[2 * j + 1] * r * g1); }
}
DI void p0_prologue(const Ptrs& P, LAS unsigned char* lds, int vcu, int G, int wave, int lane) {
    LAS float* scr = (LAS float*)(lds + wave * 16384);
    const int gw = vcu * NWAVES + wave, NGW = G * NWAVES;
    unsigned char* wb = P.ws + WS_W;
    constexpr int I_FI = 16 * 176, I_FO = 44 * 32, I_PI = 4 * 32, I_SQ = 16 * 32, I_NI = 16 * 88, I_HI = 16 * 128, I_C1 = 32 * 2, I_C2 = 2;
    constexpr int NITEMS = 4 * I_FI + 4 * I_FO + 2 * I_PI + 2 * I_SQ + I_NI + I_SQ + I_HI + I_SQ + 2 * I_C1 + 2 * I_C2;
    for (int it0 = gw; it0 < NITEMS; it0 += NGW) {
        int it = it0; bool done = false;
        for (int m = 0; m < 4 && !done; ++m) done = conv_matrix<1>(it, P.ffn_in + (size_t)m * DM * 2 * DFF, 2 * DFF, DM, 2 * DFF, (h16*)(wb + W_FI + m * W_FI_SZ), scr, lane);
        for (int m = 0; m < 4 && !done; ++m) done = conv_matrix<0>(it, P.ffn_out + (size_t)m * DFF * DM, DM, DFF, DM, (h16*)(wb + W_FO + m * W_FO_SZ), scr, lane);
        for (int m = 0; m < 2 && !done; ++m) done = conv_matrix<0>(it, P.ple_in + (size_t)m * PLED * DM, DM, PLED, DM, (h16*)(wb + W_PI + m * W_PI_SZ), scr, lane);
        for (int m = 0; m < 2 && !done; ++m) done = conv_matrix<0>(it, P.ple_gate + (size_t)m * DM * DM, DM, DM, DM, (h16*)(wb + W_PG + m * W_SQ_SZ), scr, lane);
        if (!done) done = conv_matrix<2>(it, P.nsa_in, NSA_IN, DM, NSA_NP, (h16*)(wb + W_NI), scr, lane);
        if (!done) done = conv_matrix<0>(it, P.nsa_out, DM, DM, DM, (h16*)(wb + W_NO), scr, lane);
        if (!done) done = conv_matrix<0>(it, P.hg_in, 4096, DM, 4096, (h16*)(wb + W_HI), scr, lane);
        if (!done) done = conv_matrix<0>(it, P.hg_out, DM, DM, DM, (h16*)(wb + W_HO), scr, lane);
        for (int m = 0; m < 2 && !done; ++m) done = conv_matrix<0>(it, P.cmp_w1 + (size_t)m * 2048 * 64, 64, 2048, 64, (h16*)(wb + W_C1 + m * W_C1_SZ), scr, lane);
        for (int m = 0; m < 2 && !done; ++m) done = conv_matrix<0>(it, P.cmp_w2 + (size_t)m * 64 * 64, 64, 64, 64, (h16*)(wb + W_C2 + m * W_C2_SZ), scr, lane);
    }
    h16* Hb = (h16*)(P.ws + WS_H);
    for (int m = gw; m < T; m += NGW) rms_row_to_h16(P.x + (size_t)m * DM, P.ng, Hb + (size_t)m * DM, nullptr, lane);
    { const size_t n4 = (size_t)DEPTH * T * PLED / 4; const GAS f32x4* src = (const GAS f32x4*)P.p; GAS u32x2* dst = (GAS u32x2*)(P.ws + WS_PH);
      for (size_t i = (size_t)gw * 64 + lane; i < n4; i += (size_t)NGW * 64) { const f32x4 v = src[i]; u32x2 o; o.x = pkh(v.x, v.y); o.y = pkh(v.z, v.w); dst[i] = o; } }
    { float* rc = (float*)(P.ws + WS_ROPE_C); float* rs = (float*)(P.ws + WS_ROPE_S);
      for (int i = gw * 64 + lane; i < SEQ * 32; i += NGW * 64) { const int pos = i >> 5, k = i & 31;
          const float inv = (float)pow(10000.0, -(double)k / 32.0); const float ang = (float)pos * inv;
          rc[i] = (float)cos((double)ang); rs[i] = (float)sin((double)ang); } }
    { float* lb = (float*)(P.ws + WS_MISC + 4096);
      for (int i = gw * 64 + lane; i < 1024; i += NGW * 64) { const float l0 = P.hg_lb[i], l1 = P.hg_lb[1024 + i]; const float mx = fmaxf(l0, l1);
          const float e0 = expf(l0 - mx), e1 = expf(l1 - mx); lb[i] = e1 / (e0 + e1); } }
    if (gw < 128) { const int kv = gw >> 6, o = gw & 63; const float* pos = P.cmp_pos + kv * 2048; const float* w1 = P.cmp_w1 + (size_t)kv * 2048 * 64;
        float s = 0.f; for (int k = lane; k < 2048; k += 64) s += pos[k] * w1[(size_t)k * 64 + o];
        s = wave_sum(s); if (lane == 0) ((float*)(P.ws + WS_MISC))[gw] = s; }
}

DI void thin_phase(const float* xin, float* x, const h16* y, const float* gpost, float alpha, const float* gpre, h16* hout, int vcu, int G, int wave, int lane) {
    const int gw = vcu * NWAVES + wave, NGW = G * NWAVES;
    f32x4 gp[4], gq[4];
#pragma unroll
    for (int j = 0; j < 2; ++j) { gp[2 * j] = ((const GAS f32x4*)gpost)[2 * lane + 128 * j]; gp[2 * j + 1] = ((const GAS f32x4*)gpost)[2 * lane + 1 + 128 * j];
        if (gpre) { gq[2 * j] = ((const GAS f32x4*)gpre)[2 * lane + 128 * j]; gq[2 * j + 1] = ((const GAS f32x4*)gpre)[2 * lane + 1 + 128 * j]; } }
    for (int m = gw; m < T; m += NGW) {
        GAS f32x4* xr = (GAS f32x4*)(x + (size_t)m * DM); const GAS f32x4* xi = (const GAS f32x4*)(xin + (size_t)m * DM); const GAS h16x8* yr = (const GAS h16x8*)(y + (size_t)m * DM);
        f32x4 xv[4], yv[4]; float s = 0.f;
#pragma unroll
        for (int j = 0; j < 2; ++j) { const h16x8 t = yr[lane + 64 * j];
            yv[2 * j] = (f32x4){(float)t[0], (float)t[1], (float)t[2], (float)t[3]}; yv[2 * j + 1] = (f32x4){(float)t[4], (float)t[5], (float)t[6], (float)t[7]};
            xv[2 * j] = xi[2 * lane + 128 * j]; xv[2 * j + 1] = xi[2 * lane + 1 + 128 * j]; }
#pragma unroll
        for (int j = 0; j < 4; ++j) s += (yv[j].x * yv[j].x + yv[j].y * yv[j].y) + (yv[j].z * yv[j].z + yv[j].w * yv[j].w);
        const float r = rsqrtf(wave_sum(s) * (1.f / DM) + NORM_EPS) * alpha; float s2 = 0.f;
#pragma unroll
        for (int j = 0; j < 4; ++j) { xv[j] = xv[j] + yv[j] * r * gp[j]; s2 += (xv[j].x * xv[j].x + xv[j].y * xv[j].y) + (xv[j].z * xv[j].z + xv[j].w * xv[j].w); }
#pragma unroll
        for (int j = 0; j < 2; ++j) { xr[2 * lane + 128 * j] = xv[2 * j]; xr[2 * lane + 1 + 128 * j] = xv[2 * j + 1]; }
        if (gpre) { const float r2 = rsqrtf(wave_sum(s2) * (1.f / DM) + NORM_EPS);
#pragma unroll
            for (int j = 0; j < 2; ++j) *(GAS u32x4*)(hout + (size_t)m * DM + 8 * lane + 512 * j) = pkh8(xv[2 * j] * r2 * gq[2 * j], xv[2 * j + 1] * r2 * gq[2 * j + 1]); }
    }
}

struct EpiPlain {
    static constexpr bool PERM = true, AFTER_DRAIN = false;
    h16* O; int ldc;
    DI void operator()(const f32x4 (&acc)[2][2][4][2], const pg8::Unit& u, int wr, int wc, int fr_, int fq_) const {
        int fr = fr_, fq = fq_; asm volatile("" : "+v"(fr), "+v"(fq));
        const int row0 = u.pm * 256 + wr * 64 + fr, col0 = u.pn * 256 + wc * 32 + 8 * fq;
#pragma unroll
        for (int ai = 0; ai < 2; ++ai)
#pragma unroll
            for (int m = 0; m < 4; ++m) { h16* rowp = O + (size_t)(row0 + ai * 128 + m * 16) * ldc + col0;
#pragma unroll
                for (int bj = 0; bj < 2; ++bj) *(GAS u32x4*)(rowp + bj * 128) = pkh8(acc[ai][bj][m][0], acc[ai][bj][m][1]); }
    }
};
struct EpiSwiglu {
    static constexpr bool PERM = true, AFTER_DRAIN = false;
    h16* O;
    DI void operator()(const f32x4 (&acc)[2][2][4][2], const pg8::Unit& u, int wr, int wc, int fr_, int fq_) const {
        int fr = fr_, fq = fq_; asm volatile("" : "+v"(fr), "+v"(fq));
        const int row0 = u.pm * 256 + wr * 64 + fr, col0 = u.pn * 128 + wc * 32 + 8 * fq;
#pragma unroll
        for (int ai = 0; ai < 2; ++ai)
#pragma unroll
            for (int m = 0; m < 4; ++m) { f32x4 v[2];
#pragma unroll
                for (int n = 0; n < 2; ++n)
#pragma unroll
                    for (int i = 0; i < 4; ++i) v[n][i] = siluf_(acc[ai][0][m][n][i]) * acc[ai][1][m][n][i];
                *(GAS u32x4*)(O + (size_t)(row0 + ai * 128 + m * 16) * DFF + col0) = pkh8(v[0], v[1]); }
    }
};
struct EpiPleGate {
    static constexpr bool PERM = true, AFTER_DRAIN = false;
    const h16* PE; h16* O;
    DI void operator()(const f32x4 (&acc)[2][2][4][2], const pg8::Unit& u, int wr, int wc, int fr_, int fq_) const {
        int fr = fr_, fq = fq_; asm volatile("" : "+v"(fr), "+v"(fq));
        const int row0 = u.pm * 256 + wr * 64 + fr, col0 = u.pn * 256 + wc * 32 + 8 * fq;
#pragma unroll
        for (int ai = 0; ai < 2; ++ai)
#pragma unroll
            for (int m = 0; m < 4; ++m)
#pragma unroll
                for (int bj = 0; bj < 2; ++bj) { const size_t off = (size_t)(row0 + ai * 128 + m * 16) * DM + col0 + bj * 128;
                    asm volatile("" ::: "memory");
                    const h16x8 pe = *(const GAS h16x8*)(PE + off); f32x4 v[2];
#pragma unroll
                    for (int n = 0; n < 2; ++n)
#pragma unroll
                        for (int i = 0; i < 4; ++i) v[n][i] = (float)pe[4 * n + i] * sigmoidf_(acc[ai][bj][m][n][i]);
                    *(GAS u32x4*)(O + off) = pkh8(v[0], v[1]); }
    }
};
struct EpiNsaIn {
    static constexpr bool PERM = true, AFTER_DRAIN = false;
    unsigned char* xb; const float* rc; const float* rs; unsigned* kmax;
    DI void operator()(const f32x4 (&acc)[2][2][4][2], const pg8::Unit& u, int wr, int wc, int fr_, int fq_) const {
        int fr = fr_, fq = fq_; asm volatile("" : "+v"(fr), "+v"(fq));
        const int row0 = u.pm * 256 + wr * 64 + fr; const int pn = u.pn;
        if (pn == 10) {
            float* gt = (float*)(xb + X_GATES); const int j0 = wc * 32 + 8 * fq;
#pragma unroll
            for (int ai = 0; ai < 2; ++ai)
#pragma unroll
                for (int m = 0; m < 4; ++m) { const int row = row0 + ai * 128 + m * 16;
#pragma unroll
                    for (int n = 0; n < 2; ++n) { const int j = j0 + 4 * n; if (j < 48) { f32x4 g;
#pragma unroll
                        for (int i = 0; i < 4; ++i) g[i] = sigmoidf_(acc[ai][0][m][n][i]);
                        *(GAS f32x4*)(gt + (size_t)row * 48 + j) = g; } } }
            return;
        }
        const bool rope = (pn < 4) || pn == 4 || pn == 6 || pn == 8;
        const float sc = (pn < 4) ? 0.125f * LOG2E : 1.0f;
        h16* dst; int ld, colb;
        if (pn < 4) { dst = (h16*)(xb + X_Q); ld = 1024; colb = (4 * pn + wc) * 64; }
        else { dst = (h16*)(xb + X_KC + (size_t)(pn - 4) * 16 * MiB); ld = 64; colb = 0; }
        const int d0 = 8 * fq; float nrm = 0.f;
#pragma unroll
        for (int ai = 0; ai < 2; ++ai)
#pragma unroll
            for (int m = 0; m < 4; ++m) { const int row = row0 + ai * 128 + m * 16;
                asm volatile("" ::: "memory");
                f32x4 o1[2], o2[2];
                if (rope) { const int pos = row & (SEQ - 1);
#pragma unroll
                    for (int n = 0; n < 2; ++n) { const f32x4 c = *(const GAS f32x4*)(rc + pos * 32 + d0 + 4 * n), s = *(const GAS f32x4*)(rs + pos * 32 + d0 + 4 * n);
                        const f32x4 x1 = acc[ai][0][m][n], x2 = acc[ai][1][m][n];
                        o1[n] = (x1 * c - x2 * s) * sc; o2[n] = (x2 * c + x1 * s) * sc; } }
                else { o1[0] = acc[ai][0][m][0]; o1[1] = acc[ai][0][m][1]; o2[0] = acc[ai][1][m][0]; o2[1] = acc[ai][1][m][1]; }
                const size_t rrow = (pn < 4) ? (size_t)row : ((size_t)((row >> 14) * NG + wc) * SEQ + (row & (SEQ - 1)));
                h16* rp = dst + rrow * ld + colb + d0;
                const u32x4 w1 = pkh8(o1[0], o1[1]), w2 = pkh8(o2[0], o2[1]);
                *(GAS u32x4*)(rp) = w1; *(GAS u32x4*)(rp + 32) = w2;
                if (pn == 6 || pn == 8) {
                    const h16x8 a8 = __builtin_bit_cast(h16x8, w1), b8 = __builtin_bit_cast(h16x8, w2); float s = 0.f;
#pragma unroll
                    for (int i = 0; i < 8; ++i) s += (float)a8[i] * (float)a8[i] + (float)b8[i] * (float)b8[i];
                    s += __shfl_xor(s, 16); s += __shfl_xor(s, 32);
                    nrm = fmaxf(nrm, s); } }
        if (pn == 6 || pn == 8) {
#pragma unroll
            for (int o = 1; o < 16; o <<= 1) nrm = fmaxf(nrm, __shfl_xor(nrm, o));
            if ((fr | fq) == 0) atomicMax(kmax + ((row0 >> 14) * NG + wc) * 2 + (pn == 8 ? 1 : 0), __float_as_uint(nrm)); }
    }
};
struct EpiHgIn {
    static constexpr bool PERM = true, AFTER_DRAIN = false;
    unsigned char* xb; h16* GH; const float* lb;
    DI void operator()(const f32x4 (&acc)[2][2][4][2], const pg8::Unit& u, int wr, int wc, int fr_, int fq_) const {
        int fr = fr_, fq = fq_; asm volatile("" : "+v"(fr), "+v"(fq));
        const int row0 = u.pm * 256 + wr * 64 + fr; const int kind = u.pn >> 2; const int col0 = (u.pn & 3) * 256 + wc * 32 + 8 * fq;
        h16* dst = kind == 0 ? (h16*)(xb + X_QH) : kind == 1 ? (h16*)(xb + X_LF) : kind == 2 ? (h16*)(xb + X_VH) : GH;
        f32x4 lbv[2][2];
        if (kind == 1) {
#pragma unroll
            for (int bj = 0; bj < 2; ++bj)
#pragma unroll
                for (int n = 0; n < 2; ++n) lbv[bj][n] = *(const GAS f32x4*)(lb + col0 + bj * 128 + 4 * n); }
#pragma unroll
        for (int ai = 0; ai < 2; ++ai)
#pragma unroll
            for (int m = 0; m < 4; ++m)
#pragma unroll
                for (int bj = 0; bj < 2; ++bj) { f32x4 v[2];
                    asm volatile("" ::: "memory");
#pragma unroll
                    for (int n = 0; n < 2; ++n)
#pragma unroll
                        for (int i = 0; i < 4; ++i) { const float a = acc[ai][bj][m][n][i]; float r;
                            if (kind == 0 || kind == 3) r = siluf_(a);
                            else if (kind == 1) { const float l = lbv[bj][n][i]; r = __logf(l + (1.f - l) * sigmoidf_(a)); }
                            else r = a;
                            v[n][i] = r; }
                    *(GAS u32x4*)(dst + (size_t)(row0 + ai * 128 + m * 16) * DM + col0 + bj * 128) = pkh8(v[0], v[1]); }
    }
};

constexpr int CX_STR = 72;
DI void compress_phase(unsigned char* ws, LAS unsigned char* lds, int wgi, int G, int tid) {
    const int wave = __builtin_amdgcn_readfirstlane(tid >> 6), lane = tid & 63, fr = lane & 15, fq = lane >> 4;
    LAS h16* X = (LAS h16*)lds;
    LAS h16* MID = (LAS h16*)(lds + 528 * CX_STR * 2);
    const int mt = wave >> 2, nt = wave & 3;
    for (int u = wgi; u < 512; u += G) {
        const int kv = u >> 8, b = (u >> 7) & 1, g = (u >> 5) & 3, nb = u & 31, n0 = 32 * nb;
        const h16* src = (const h16*)(ws + WS_X + (kv ? X_VC : X_KC)) + (size_t)(b * NG + g) * SEQ * 64;
        for (int i = tid; i < 528 * 8; i += NTHREADS) { const int r = i >> 3, ch = i & 7; int tok = 16 * n0 + r; tok = tok < SEQ ? tok : SEQ - 1;
            *(LAS u32x4*)(X + r * CX_STR + ch * 8) = *(const GAS u32x4*)(src + (size_t)tok * 64 + ch * 8); }
        __syncthreads();
        const h16* w1t = (const h16*)(ws + WS_W + W_C1 + kv * W_C1_SZ) + (size_t)(16 * nt + fr) * 2048 + 8 * fq;
        f32x4 acc = {0.f, 0.f, 0.f, 0.f};
#pragma unroll 16
        for (int s = 0; s < 64; ++s) {
            const h16x8 a = *(const LAS h16x8*)(X + (16 * (16 * mt + fr) + (s >> 1)) * CX_STR + 32 * (s & 1) + 8 * fq);
            const h16x8 bw = *(const GAS h16x8*)(w1t + 32 * s);
            acc = __builtin_amdgcn_mfma_f32_16x16x32_f16(a, bw, acc, 0, 0, 0);
        }
        const float bias = ((const float*)(ws + WS_MISC))[kv * 64 + 16 * nt + fr];
#pragma unroll
        for (int i = 0; i < 4; ++i) MID[(16 * mt + 4 * fq + i) * CX_STR + 16 * nt + fr] = (h16)siluf_(acc[i] + bias);
        __syncthreads();
        const h16* w2t = (const h16*)(ws + WS_W + W_C2 + kv * W_C2_SZ) + (size_t)(16 * nt + fr) * 64 + 8 * fq;
        f32x4 acc2 = {0.f, 0.f, 0.f, 0.f};
#pragma unroll
        for (int s = 0; s < 2; ++s) {
            const h16x8 a = *(const LAS h16x8*)(MID + (16 * mt + fr) * CX_STR + 32 * s + 8 * fq);
            const h16x8 bw = *(const GAS h16x8*)(w2t + 32 * s);
            acc2 = __builtin_amdgcn_mfma_f32_16x16x32_f16(a, bw, acc2, 0, 0, 0);
        }
        h16* dst = (h16*)(ws + WS_X + (kv ? X_VCMP : X_KCMP)) + (size_t)(b * NG + g) * NCMP_P * 64;
#pragma unroll
        for (int i = 0; i < 4; ++i) { const int n = n0 + 16 * mt + 4 * fq + i; dst[(size_t)n * 64 + 16 * nt + fr] = (n < NCMP) ? (h16)acc2[i] : (h16)0.f; }
        __syncthreads();
    }
}

constexpr int AT_IMP = 49152, AT_SELM = LDSCTL_OFF + 1024, AT_END = AT_SELM + 2048;
static_assert(AT_IMP + 65536 <= RING_BYTES && AT_END <= LDS_BYTES, "attention LDS map");
constexpr float M_INIT = -1e30f, M_MASK = -3e30f;

DI int opaque(int x) { asm volatile("" : "+v"(x)); return x; }
#define WG_BAR() do { asm volatile("s_waitcnt lgkmcnt(0)" ::: "memory"); __builtin_amdgcn_s_barrier(); asm volatile("" ::: "memory"); } while (0)

DI float quad_sum(float v) {
    v += __builtin_bit_cast(float, __builtin_amdgcn_update_dpp(0, __builtin_bit_cast(int, v), 0xB1, 0xF, 0xF, true));
    v += __builtin_bit_cast(float, __builtin_amdgcn_update_dpp(0, __builtin_bit_cast(int, v), 0x4E, 0xF, 0xF, true));
    return v;
}
DI float col_max(float v) {
    const auto a = __builtin_amdgcn_permlane16_swap(__float_as_uint(v), __float_as_uint(v), false, false);
    const unsigned a0 = a[0], a1 = a[1];
    v = fmaxf(__uint_as_float(a0), __uint_as_float(a1));
    const auto b = __builtin_amdgcn_permlane32_swap(__float_as_uint(v), __float_as_uint(v), false, false);
    const unsigned b0 = b[0], b1 = b[1];
    return fmaxf(__uint_as_float(b0), __uint_as_float(b1));
}
DI float col_sum(float v) { v += __shfl_xor(v, 16); v += __shfl_xor(v, 32); return v; }

DI void glds16(const void* gsrc, unsigned lds_dst) { unsigned keep;
    asm volatile("s_mov_b32 %0, m0\n\ts_mov_b32 m0, %2\n\ts_nop 0\n\tglobal_load_lds_dwordx4 %1, off\n\ts_mov_b32 m0, %0" : "=&s"(keep) : "v"(gsrc), "s"(lds_dst) : "memory"); }
DI void sel_dma_tile(const h16* Kg, const h16* Vg, int ld, int t, LAS unsigned char* slot, int wave, int lane) {
    lane = opaque(lane);
    const int rl = lane >> 3, row = 8 * wave + rl, ch = (lane & 7) ^ rl;
    const unsigned goff = (unsigned)(((64 * t + row) * ld + ch * 8) * 2);
    const unsigned dst = (unsigned)(uintptr_t)(slot + wave * 1024);
    glds16((const char*)Kg + goff, dst);
    glds16((const char*)Vg + goff, dst + 8192u);
}
DI void at_kread(h16x8 (&kf)[8], const LAS h16* Kb, int fr, int fq) {
    const int r7 = fr & 7;
#pragma unroll
    for (int kb = 0; kb < 4; ++kb) { kf[2 * kb] = *(const LAS h16x8*)(Kb + (16 * kb + fr) * 64 + ((fq ^ r7) * 8)); kf[2 * kb + 1] = *(const LAS h16x8*)(Kb + (16 * kb + fr) * 64 + (((4 + fq) ^ r7) * 8)); }
    __builtin_amdgcn_sched_barrier(0);
}
DI void at_qk_mma(f32x4 (&st)[2][4], const h16x8 (&kf)[8], const h16x8 (&qf)[2][2], const float (&bias)[2], bool need0, bool need1) {
#pragma unroll
    for (int kb = 0; kb < 4; ++kb) {
        if (need0) { const f32x4 z = {bias[0], bias[0], bias[0], bias[0]}; st[0][kb] = __builtin_amdgcn_mfma_f32_16x16x32_f16(kf[2 * kb], qf[0][0], z, 0, 0, 0); st[0][kb] = __builtin_amdgcn_mfma_f32_16x16x32_f16(kf[2 * kb + 1], qf[0][1], st[0][kb], 0, 0, 0); }
        if (need1) { const f32x4 z = {bias[1], bias[1], bias[1], bias[1]}; st[1][kb] = __builtin_amdgcn_mfma_f32_16x16x32_f16(kf[2 * kb], qf[1][0], z, 0, 0, 0); st[1][kb] = __builtin_amdgcn_mfma_f32_16x16x32_f16(kf[2 * kb + 1], qf[1][1], st[1][kb], 0, 0, 0); }
    }
}
DI void at_vread(h16x8 (&vf)[8], const LAS h16* Vb, int fr, int fq) {
    const int q = fr >> 2, k7 = 4 * (fq & 1) + q, cl = (fr & 3) >> 1, in4 = 4 * (fr & 1);
#pragma unroll
    for (int s2 = 0; s2 < 2; ++s2)
#pragma unroll
        for (int db = 0; db < 4; ++db) {
            const LAS h16* p0 = Vb + (32 * s2 + 4 * fq + q) * 64 + (((2 * db + cl) ^ k7) * 8) + in4;
            const s16x4 r0 = __builtin_amdgcn_ds_read_tr16_b64_v4i16((LAS s16x4*)p0);
            const s16x4 r1 = __builtin_amdgcn_ds_read_tr16_b64_v4i16((LAS s16x4*)(p0 + 16 * 64));
            vf[4 * s2 + db] = __builtin_bit_cast(h16x8, __builtin_shufflevector(r0, r1, 0, 1, 2, 3, 4, 5, 6, 7)); }
    __builtin_amdgcn_sched_barrier(0);
}
DI void at_pv_mma(f32x4 (&o)[2][4], const h16x8 (&vf)[8], const h16x8 (&pb)[2][2], bool need0, bool need1) {
#pragma unroll
    for (int s2 = 0; s2 < 2; ++s2)
#pragma unroll
        for (int db = 0; db < 4; ++db) {
            if (need0) o[0][db] = __builtin_amdgcn_mfma_f32_16x16x32_f16(vf[4 * s2 + db], pb[0][s2], o[0][db], 0, 0, 0);
            if (need1) o[1][db] = __builtin_amdgcn_mfma_f32_16x16x32_f16(vf[4 * s2 + db], pb[1][s2], o[1][db], 0, 0, 0);
        }
}
DI h16x8 pack_p(const f32x4& a, const f32x4& b) { return __builtin_bit_cast(h16x8, pkh8(a, b)); }
DI void at_expsum(f32x4 (&st)[4], float& lrun, h16x8 (&pb)[2]) {
    float sum = 0.f;
#pragma unroll
    for (int kb = 0; kb < 4; ++kb)
#pragma unroll
        for (int i = 0; i < 4; ++i) { const float pp = __builtin_amdgcn_exp2f(st[kb][i]); st[kb][i] = pp; sum += pp; }
    lrun += sum;
    pb[0] = pack_p(st[0], st[1]); pb[1] = pack_p(st[2], st[3]);
}
#define DN_PIPE_BEGIN(Kg, Vg, ld, first, last)                                                                           \
    { sel_dma_tile(Kg, Vg, ld, (first), lds, wave, lane);                                                                \
      if ((first) + 1 <= (last)) sel_dma_tile(Kg, Vg, ld, (first) + 1, lds + 16384, wave, lane);                         \
      int sl_ = 0;                                                                                                       \
      for (int t_ = (first); t_ <= (last); ++t_) {                                                                       \
          if (t_ + 1 <= (last)) asm volatile("s_waitcnt vmcnt(2)" ::: "memory"); else asm volatile("s_waitcnt vmcnt(0)" ::: "memory");   \
          WG_BAR();                                                                                                      \
          { const int s2_ = sl_ >= 1 ? sl_ - 1 : 2; if (t_ + 2 <= (last)) sel_dma_tile(Kg, Vg, ld, t_ + 2, lds + s2_ * 16384, wave, lane); }   \
          const LAS h16* Kb = (const LAS h16*)(lds + sl_ * 16384); const LAS h16* Vb = Kb + 4096; (void)Vb;
#define DN_PIPE_END                                                                                                      \
          sl_ = sl_ == 2 ? 0 : sl_ + 1; }                                                                                \
      WG_BAR(); }

DI void attn_phase(unsigned char* ws, LAS unsigned char* lds, int wgi, int G, int tid) {
    const int wave = __builtin_amdgcn_readfirstlane(tid >> 6), lane = tid & 63, fr = lane & 15, fq = lane >> 4;
    const int tl = fr >> 2, hd = fr & 3;
    unsigned char* xb = ws + WS_X;
    LAS float* IMP = (LAS float*)(lds + AT_IMP) + wave * (8 * 256);
    LAS unsigned char* sb = (LAS unsigned char*)(lds + AT_SELM) + wave * 256;
    const float* gates = (const float*)(xb + X_GATES);
    for (int u = wgi; u < 2048; u += G) {
        const int bg = u & 7, b = bg >> 2, g = bg & 3, qq = u >> 3, ii = qq >> 5, rr = qq & 31;
        const int c = (ii & 1) ? (64 * (ii >> 1) + 63 - rr) : (64 * (ii >> 1) + rr);
        const size_t rowb = (size_t)b * SEQ;
        const int tw = 64 * c + 8 * wave;
        h16x8 qf[2][2];
#pragma unroll
        for (int a = 0; a < 2; ++a)
#pragma unroll
            for (int s = 0; s < 2; ++s)
                qf[a][s] = *(const GAS h16x8*)((const h16*)(xb + X_Q) + (rowb + tw + 4 * a + tl) * 1024 + (4 * g + hd) * 64 + 32 * s + 8 * fq);
        int tcol[2]; tcol[0] = tw + tl; tcol[1] = tw + 4 + tl;
        asm volatile("" :: "v"(qf[0][0]), "v"(qf[0][1]), "v"(qf[1][0]), "v"(qf[1][1]));
        GAS char* oscr = (GAS char*)(xb + X_OSCR + (size_t)wgi * 65536 + wave * 8192); const unsigned ooff = (unsigned)lane * 128u;
        const float zb[2] = {0.f, 0.f};
        float qn[2];
#pragma unroll
        for (int a = 0; a < 2; ++a) { float s = 0.f;
#pragma unroll
            for (int k2 = 0; k2 < 2; ++k2)
#pragma unroll
                for (int i = 0; i < 8; ++i) s += (float)qf[a][k2][i] * (float)qf[a][k2][i];
            qn[a] = sqrtf(col_sum(s)); }
        const float kmx_s = sqrtf(__uint_as_float(((const unsigned*)(ws + WS_CTL) + CW_KMAX)[(b * NG + g) * 2 + 0])) * 1.002f, kmx_w = sqrtf(__uint_as_float(((const unsigned*)(ws + WS_CTL) + CW_KMAX)[(b * NG + g) * 2 + 1])) * 1.002f;
        {
            const h16* Kg = (const h16*)(xb + X_KCMP) + (size_t)(b * NG + g) * NCMP_P * 64;
            const h16* Vg = (const h16*)(xb + X_VCMP) + (size_t)(b * NG + g) * NCMP_P * 64;
            const int ntc = (4 * c + 3 + 63) >> 6;
            const int tfull = (4 * c - 2 + 1) >> 6;
            int nmax[2];
#pragma unroll
            for (int a = 0; a < 2; ++a) nmax[a] = (tcol[a] >= 31) ? ((tcol[a] - 31) >> 4) : -1;
            f32x4 o[2][4];
#ifndef REP_CMP
#define REP_CMP 1
#endif
            _Pragma("unroll 1") for (int rep_ = 0; rep_ < REP_CMP; ++rep_) {
            float mrun[2] = {M_INIT, M_INIT}, lrun[2] = {0.f, 0.f};
            PROF_BEGIN(1);
            DN_PIPE_BEGIN(Kg, Vg, 64, 0, ntc - 1)
                h16x8 kf[8]; at_kread(kf, Kb, fr, fq); f32x4 st[2][4]; at_qk_mma(st, kf, qf, zb, true, true);
#pragma unroll
                for (int a = 0; a < 2; ++a) {
                    if (t_ >= tfull) {
#pragma unroll
                        for (int kb = 0; kb < 4; ++kb)
#pragma unroll
                            for (int i = 0; i < 4; ++i) { const int n = 64 * t_ + 16 * kb + 4 * fq + i; st[a][kb][i] = (n <= nmax[a]) ? st[a][kb][i] : M_MASK; }
                    }
                    float tmax = fmaxf(fmaxf(fmaxf(st[a][0][0], st[a][0][1]), fmaxf(st[a][0][2], st[a][0][3])), fmaxf(fmaxf(st[a][1][0], st[a][1][1]), fmaxf(st[a][1][2], st[a][1][3])));
                    tmax = fmaxf(tmax, fmaxf(fmaxf(fmaxf(st[a][2][0], st[a][2][1]), fmaxf(st[a][2][2], st[a][2][3])), fmaxf(fmaxf(st[a][3][0], st[a][3][1]), fmaxf(st[a][3][2], st[a][3][3]))));
                    const float mn = fmaxf(mrun[a], tmax); float sum = 0.f;
#pragma unroll
                    for (int kb = 0; kb < 4; ++kb)
#pragma unroll
                        for (int i = 0; i < 4; ++i) sum += __builtin_amdgcn_exp2f(st[a][kb][i] - mn);
                    lrun[a] = lrun[a] * __builtin_amdgcn_exp2f(mrun[a] - mn) + sum; mrun[a] = mn;
                }
            DN_PIPE_END
            PROF_END(1);
            float mcol[2], invl[2];
            PROF_BEGIN(2);
#pragma unroll
            for (int a = 0; a < 2; ++a) { const float mc = col_max(mrun[a]); const float lc = col_sum(lrun[a] * __builtin_amdgcn_exp2f(mrun[a] - mc)); mcol[a] = mc; invl[a] = 1.0f / fmaxf(lc, 1e-30f); }
#pragma unroll
            for (int a = 0; a < 2; ++a)
#pragma unroll
                for (int db = 0; db < 4; ++db) o[a][db] = (f32x4){0.f, 0.f, 0.f, 0.f};
            float carry[2] = {0.f, 0.f};
            const float nb2[2] = {-mcol[0], -mcol[1]};
            DN_PIPE_BEGIN(Kg, Vg, 64, 0, ntc - 1)
                h16x8 kf[8]; at_kread(kf, Kb, fr, fq); f32x4 st[2][4]; at_qk_mma(st, kf, qf, nb2, true, true);
                h16x8 vf[8]; at_vread(vf, Vb, fr, fq);
                h16x8 pb[2][2];
#pragma unroll
                for (int a = 0; a < 2; ++a) {
#pragma unroll
                    for (int kb = 0; kb < 4; ++kb)
#pragma unroll
                        for (int i = 0; i < 4; ++i) { const int n = 64 * t_ + 16 * kb + 4 * fq + i; const float e = __builtin_amdgcn_exp2f(st[a][kb][i]) * invl[a]; st[a][kb][i] = (t_ < tfull || n <= nmax[a]) ? e : 0.f; }
                    pb[a][0] = pack_p(st[a][0], st[a][1]); pb[a][1] = pack_p(st[a][2], st[a][3]);
                    if (c > 15) {
                        const int ln = opaque(lane), fq_ = ln >> 4, hd_ = ln & 3, tl_ = (ln & 15) >> 2;
                        float s4[4], p3[4], tt[4];
#pragma unroll
                        for (int kb = 0; kb < 4; ++kb) { s4[kb] = quad_sum((st[a][kb][0] + st[a][kb][1]) + (st[a][kb][2] + st[a][kb][3])); p3[kb] = quad_sum(st[a][kb][3]); }
#pragma unroll
                        for (int kb = 0; kb < 4; ++kb) tt[kb] = __shfl(p3[kb], (ln + 48) & 63);
#pragma unroll
                        for (int kb = 0; kb < 4; ++kb) { const float recv = (fq_ > 0) ? tt[kb] : (kb > 0 ? tt[kb > 0 ? kb - 1 : 0] : carry[a]);
                            const int j = 16 * t_ + 4 * kb + fq_;
                            if (hd_ == 0 && j < 256) IMP[(4 * a + tl_) * 256 + j] = s4[kb] + recv; }
                        carry[a] = tt[3];
                    }
                }
                at_pv_mma(o, vf, pb, true, true);
            DN_PIPE_END
            }
#pragma unroll
            for (int a = 0; a < 2; ++a) { const float gt = gates[(rowb + tcol[a]) * 48 + (4 * g + hd) * 3 + 0];
#pragma unroll
                for (int db = 0; db < 4; ++db) *(GAS f32x4*)(oscr + (a * 4 + db) * 16 + ooff) = o[a][db] * gt; }
        }
        PROF_END(2);
        PROF_BEGIN(3);
#ifndef REP_TOPK
#define REP_TOPK 1
#endif
        for (int rep_ = 0; rep_ < REP_TOPK; ++rep_) {
            const int lane = opaque(tid) & 63;
            unsigned bytes[4] = {0u, 0u, 0u, 0u};
            if (c <= 15) {
#pragma unroll
                for (int k = 0; k < 4; ++k) bytes[k] = (lane + 64 * k <= c) ? 0xFFu : 0u;
            } else {
#pragma unroll 1
                for (int tk0 = 0; tk0 < 8; tk0 += 4) {
                    unsigned key[4][4];
#pragma unroll
                    for (int q4 = 0; q4 < 4; ++q4)
#pragma unroll
                        for (int k = 0; k < 4; ++k) { const int j = lane + 64 * k; const unsigned ub = __builtin_bit_cast(unsigned, IMP[(tk0 + q4) * 256 + j]);
                            key[q4][k] = (j >= 1 && j <= c - 2) ? (((ub >> 7) << 8) | (unsigned)(255 - j)) : 0u; }
                    unsigned thr[4] = {0u, 0u, 0u, 0u};
#pragma unroll 1
                    for (int bit = 31; bit >= 0; --bit) {
#pragma unroll
                        for (int q4 = 0; q4 < 4; ++q4) { const unsigned cand = thr[q4] | (1u << bit); int cnt = 0;
#pragma unroll
                            for (int k = 0; k < 4; ++k) cnt += __popcll(__ballot(key[q4][k] >= cand));
                            if (cnt >= 13) thr[q4] = cand; } }
#pragma unroll
                    for (int q4 = 0; q4 < 4; ++q4)
#pragma unroll
                        for (int k = 0; k < 4; ++k) bytes[k] |= (key[q4][k] >= thr[q4] && key[q4][k] != 0u) ? (1u << (tk0 + q4)) : 0u;
                }
#pragma unroll
                for (int k = 0; k < 4; ++k) { const int j = lane + 64 * k; if (j == 0 || j == c || j == c - 1) bytes[k] = 0xFFu; }
            }
#pragma unroll
            for (int k = 0; k < 4; ++k) sb[lane + 64 * k] = (unsigned char)bytes[k];
        }
        WG_BAR();
        PROF_END(3); PROF_BEGIN(4);
        {
            const h16* Kg = (const h16*)(xb + X_KS) + (size_t)(b * NG + g) * SEQ * 64;
            const h16* Vg = (const h16*)(xb + X_VS) + (size_t)(b * NG + g) * SEQ * 64;
            float lrun[2];
            f32x4 o[2][4];
            const int nblk = c + 1, nbatch = (nblk + 3) >> 2;
#ifndef REP_SEL
#define REP_SEL 1
#endif
            for (int rep_ = 0; rep_ < REP_SEL; ++rep_) {
            lrun[0] = lrun[1] = 0.f;
#pragma unroll
            for (int a = 0; a < 2; ++a)
#pragma unroll
                for (int db = 0; db < 4; ++db) o[a][db] = (f32x4){0.f, 0.f, 0.f, 0.f};
#pragma unroll
            for (int bb = 0; bb < 4; ++bb) if (bb < nblk) sel_dma_tile(Kg, Vg, 64, bb, lds + bb * 16384, wave, lane);
            for (int e = 0; e < nbatch; ++e) {
                PROF_BEGIN(6); asm volatile("s_waitcnt vmcnt(0)" ::: "memory"); PROF_END(6); PROF_BEGIN(7); WG_BAR(); PROF_END(7);
                if (e + 1 < nbatch) {
#pragma unroll
                    for (int bb = 0; bb < 4; ++bb) { const int j = 4 * (e + 1) + bb; if (j < nblk) sel_dma_tile(Kg, Vg, 64, j, lds + (((e + 1) & 1) * 4 + bb) * 16384, wave, lane); } }
#pragma unroll 1
                for (int bb = 0; bb < 4; ++bb) {
                    const int j = 4 * e + bb; if (j >= nblk) break;
                    const unsigned tm = (unsigned)__builtin_amdgcn_readfirstlane((int)sb[j]);
                    const bool need0 = (tm & 0xFu) != 0u, need1 = (tm & 0xF0u) != 0u;
                    if (need0 || need1) {
                        const LAS h16* Kb = (const LAS h16*)(lds + ((e & 1) * 4 + bb) * 16384); const LAS h16* Vb = Kb + 4096;
                        float bias[2];
#pragma unroll
                        for (int a = 0; a < 2; ++a) bias[a] = ((tm >> (4 * a + tl)) & 1u) ? (14.f - qn[a] * kmx_s) : M_MASK;
                        h16x8 kf[8]; at_kread(kf, Kb, fr, fq); f32x4 st[2][4]; at_qk_mma(st, kf, qf, bias, need0, need1);
                        h16x8 vf[8]; at_vread(vf, Vb, fr, fq);
                        h16x8 pb[2][2];
#pragma unroll
                        for (int a = 0; a < 2; ++a) {
                            const bool need = a ? need1 : need0;
                            if (need) {
                                if (j == c) { const int tloc = tcol[a] - 64 * c;
#pragma unroll
                                    for (int kb = 0; kb < 4; ++kb)
#pragma unroll
                                        for (int i = 0; i < 4; ++i) st[a][kb][i] = (16 * kb + 4 * fq + i <= tloc) ? st[a][kb][i] : M_MASK; }
                                at_expsum(st[a], lrun[a], pb[a]);
                            } else { pb[a][0] = (h16x8){0, 0, 0, 0, 0, 0, 0, 0}; pb[a][1] = pb[a][0]; }
                        }
                        at_pv_mma(o, vf, pb, need0, need1);
                    }
                }
            }
            WG_BAR();
            }
#pragma unroll
            for (int a = 0; a < 2; ++a) { const float gt = gates[(rowb + tcol[a]) * 48 + (4 * g + hd) * 3 + 1] / fmaxf(col_sum(lrun[a]), 1e-30f);
#pragma unroll
                for (int db = 0; db < 4; ++db) o[a][db] = o[a][db] * gt; }
            { f32x4 prev[2][4];
#pragma unroll
              for (int a = 0; a < 2; ++a)
#pragma unroll
                for (int db = 0; db < 4; ++db) prev[a][db] = *(const GAS f32x4*)(oscr + (a * 4 + db) * 16 + ooff);
#pragma unroll
              for (int a = 0; a < 2; ++a)
#pragma unroll
                for (int db = 0; db < 4; ++db) *(GAS f32x4*)(oscr + (a * 4 + db) * 16 + ooff) = prev[a][db] + o[a][db]; }
        }
        PROF_END(4); PROF_BEGIN(5);
        {
            const h16* Kg = (const h16*)(xb + X_KW) + (size_t)(b * NG + g) * SEQ * 64;
            const h16* Vg = (const h16*)(xb + X_VW) + (size_t)(b * NG + g) * SEQ * 64;
            float lrun[2];
            f32x4 o[2][4];
            const int j0 = c >= 8 ? c - 8 : 0;
            const float wbias[2] = {14.f - qn[0] * kmx_w, 14.f - qn[1] * kmx_w};
#ifndef REP_WIN
#define REP_WIN 1
#endif
            for (int rep_ = 0; rep_ < REP_WIN; ++rep_) {
            lrun[0] = lrun[1] = 0.f;
#pragma unroll
            for (int a = 0; a < 2; ++a)
#pragma unroll
                for (int db = 0; db < 4; ++db) o[a][db] = (f32x4){0.f, 0.f, 0.f, 0.f};
            DN_PIPE_BEGIN(Kg, Vg, 64, j0, c)
                h16x8 kf[8]; at_kread(kf, Kb, fr, fq); f32x4 st[2][4]; at_qk_mma(st, kf, qf, wbias, true, true);
                h16x8 vf[8]; at_vread(vf, Vb, fr, fq);
                h16x8 pb[2][2];
#pragma unroll
                for (int a = 0; a < 2; ++a) {
                    if (t_ == c || t_ == c - 8) {
#pragma unroll
                        for (int kb = 0; kb < 4; ++kb)
#pragma unroll
                            for (int i = 0; i < 4; ++i) { const int kt = 64 * t_ + 16 * kb + 4 * fq + i; st[a][kb][i] = ((kt <= tcol[a]) && (kt > tcol[a] - 512)) ? st[a][kb][i] : M_MASK; }
                    }
                    at_expsum(st[a], lrun[a], pb[a]);
                }
                at_pv_mma(o, vf, pb, true, true);
            DN_PIPE_END
            }
#pragma unroll
            for (int a = 0; a < 2; ++a) { const float gt = gates[(rowb + tcol[a]) * 48 + (4 * g + hd) * 3 + 2] / fmaxf(col_sum(lrun[a]), 1e-30f);
#pragma unroll
                for (int db = 0; db < 4; ++db) o[a][db] = o[a][db] * gt; }
            { f32x4 prev[2][4];
#pragma unroll
              for (int a = 0; a < 2; ++a)
#pragma unroll
                for (int db = 0; db < 4; ++db) prev[a][db] = *(const GAS f32x4*)(oscr + (a * 4 + db) * 16 + ooff);
#pragma unroll
              for (int a = 0; a < 2; ++a)
#pragma unroll
                for (int db = 0; db < 4; ++db) { const f32x4 ot = prev[a][db] + o[a][db];
                    u32x2 w; w.x = pkh(ot[0], ot[1]); w.y = pkh(ot[2], ot[3]);
                    *(GAS u32x2*)((h16*)(ws + WS_H) + (rowb + tcol[a]) * 1024 + (4 * g + hd) * 64 + 16 * db + 4 * fq) = w; } }
        }
        PROF_END(5);
    }
}

constexpr int HQ_STR = 136;
constexpr int HK_STR = 24;
constexpr int HL_QT = 0, HL_KT = HL_QT + 16 * HQ_STR * 2, HL_KH = HL_KT + 16 * HQ_STR * 2, HL_VT = HL_KH + 128 * HK_STR * 2;
constexpr int HL_DEC = HL_VT + 128 * HK_STR * 2, HL_PART = HL_DEC + 512, HL_RED = HL_PART + 2048, HL_END = HL_RED + 512;
template <bool OUT> DI void hgrn_phase(unsigned char* ws, const float* hg_norm, LAS unsigned char* lds, int wgi, int G, int tid) {
    const int wave = __builtin_amdgcn_readfirstlane(tid >> 6), lane = tid & 63, fr = lane & 15, fq = lane >> 4;
    unsigned char* xb = ws + WS_X;
    LAS __bf16* QT = (LAS __bf16*)(lds + HL_QT); LAS __bf16* KT = (LAS __bf16*)(lds + HL_KT);
    LAS __bf16* KH = (LAS __bf16*)(lds + HL_KH); LAS __bf16* VT = (LAS __bf16*)(lds + HL_VT);
    LAS float* DEC = (LAS float*)(lds + HL_DEC); LAS float* PART = (LAS float*)(lds + HL_PART); LAS float* RED = (LAS float*)(lds + HL_RED);
    const int d = tid & 127, part = tid >> 7;
    float* ST = (float*)(xb + X_ST); float* DT = (float*)(xb + X_DT);
    for (int u = wgi; u < 256; u += G) {
        const int b = u >> 7, h = (u >> 4) & 7, sc = u & 15;
        const size_t row0 = (size_t)b * SEQ + (size_t)sc * 1024;
        const h16* qg = (const h16*)(xb + X_QH) + row0 * DM + h * 128 + d;
        const h16* fg = (const h16*)(xb + X_LF) + row0 * DM + h * 128 + d;
        const h16* vg = (const h16*)(xb + X_VH) + row0 * DM + h * 128 + d;
        f32x4 S[8];
#pragma unroll
        for (int db = 0; db < 8; ++db) S[db] = (f32x4){0.f, 0.f, 0.f, 0.f};
        if (OUT) {
            for (int i = 0; i < sc; ++i) { const float* st = ST + (size_t)(u - sc + i) * 16384; const float* dt = DT + (size_t)(u - sc + i) * 128;
#pragma unroll
                for (int db = 0; db < 8; ++db) { const f32x4 dv = *(const GAS f32x4*)(dt + 16 * db + 4 * fq);
#pragma unroll
                    for (int k = 0; k < 4; ++k) S[db][k] = S[db][k] * dv[k] + st[(size_t)(16 * db + 4 * fq + k) * 128 + 16 * wave + fr]; } }
        }
        float qv[4], lv[4], vv[4]; float dsum = 0.f;
#pragma unroll
        for (int k = 0; k < 4; ++k) { const size_t o = (size_t)(4 * part + k) * DM; qv[k] = (float)qg[o]; lv[k] = (float)fg[o]; vv[k] = (float)vg[o]; }
        for (int step = 0; step < 64; ++step) {
            float cum[4]; cum[0] = lv[0]; cum[1] = cum[0] + lv[1]; cum[2] = cum[1] + lv[2]; cum[3] = cum[2] + lv[3];
            PART[part * 128 + d] = cum[3];
            __syncthreads();
            float off = 0.f, tot = 0.f;
#pragma unroll
            for (int pp = 0; pp < 4; ++pp) { const float v = PART[pp * 128 + d]; tot += v; if (pp < part) off += v; }
            { b16x4 qt, kt, kh, vt;
#pragma unroll
              for (int k = 0; k < 4; ++k) { const float bt = off + cum[k]; const float kk = -expm1f(lv[k]);
                  const float eb = __expf(bt);
                  if (OUT) { QT[(4 * part + k) * HQ_STR + d] = (__bf16)(qv[k] * eb); KT[(4 * part + k) * HQ_STR + d] = (__bf16)(kk * __expf(fminf(-bt, 80.f))); }
                  kh[k] = (__bf16)(kk * __expf(tot - bt)); vt[k] = (__bf16)vv[k]; }
              *(LAS b16x4*)(KH + d * HK_STR + 4 * part) = kh; *(LAS b16x4*)(VT + d * HK_STR + 4 * part) = vt; }
            if (part == 0) { DEC[d] = __expf(tot); dsum += tot; }
            if (step + 1 < 64) {
#pragma unroll
                for (int k = 0; k < 4; ++k) { const size_t o = (size_t)(16 * (step + 1) + 4 * part + k) * DM; qv[k] = (float)qg[o]; lv[k] = (float)fg[o]; vv[k] = (float)vg[o]; } }
            __syncthreads();
            f32x4 ot = {0.f, 0.f, 0.f, 0.f};
            if (OUT) {
                f32x4 at = {0.f, 0.f, 0.f, 0.f};
#pragma unroll
                for (int ks = 0; ks < 4; ++ks) { const b16x8 ka = *(const LAS b16x8*)(KT + fr * HQ_STR + 32 * ks + 8 * fq); const b16x8 qb = *(const LAS b16x8*)(QT + fr * HQ_STR + 32 * ks + 8 * fq);
                    at = __builtin_amdgcn_mfma_f32_16x16x32_bf16(ka, qb, at, 0, 0, 0); }
#pragma unroll
                for (int i = 0; i < 4; ++i) at[i] = (4 * fq + i <= fr) ? at[i] : 0.f;
                { const b16x4 v4 = *(const LAS b16x4*)(VT + (16 * wave + fr) * HK_STR + 4 * fq);
                  const b16x8 va = {v4[0], v4[1], v4[2], v4[3], (__bf16)0.f, (__bf16)0.f, (__bf16)0.f, (__bf16)0.f};
                  u32x4 pw; pw.x = pkb(at[0], at[1]); pw.y = pkb(at[2], at[3]); pw.z = 0u; pw.w = 0u;
                  ot = __builtin_amdgcn_mfma_f32_16x16x32_bf16(va, __builtin_bit_cast(b16x8, pw), ot, 0, 0, 0); }
#pragma unroll
                for (int ks = 0; ks < 4; ++ks) { u32x4 sw; sw.x = pkb(S[2 * ks][0], S[2 * ks][1]); sw.y = pkb(S[2 * ks][2], S[2 * ks][3]); sw.z = pkb(S[2 * ks + 1][0], S[2 * ks + 1][1]); sw.w = pkb(S[2 * ks + 1][2], S[2 * ks + 1][3]);
                    const b16x4 q0 = *(const LAS b16x4*)(QT + fr * HQ_STR + 32 * ks + 4 * fq), q1 = *(const LAS b16x4*)(QT + fr * HQ_STR + 32 * ks + 16 + 4 * fq);
                    const b16x8 qb = {q0[0], q0[1], q0[2], q0[3], q1[0], q1[1], q1[2], q1[3]};
                    ot = __builtin_amdgcn_mfma_f32_16x16x32_bf16(__builtin_bit_cast(b16x8, sw), qb, ot, 0, 0, 0); }
            }
            { b16x8 vb;
              if (fq < 2) vb = *(const LAS b16x8*)(VT + (16 * wave + fr) * HK_STR + 8 * fq); else vb = (b16x8){0, 0, 0, 0, 0, 0, 0, 0};
#pragma unroll
              for (int db = 0; db < 8; ++db) { const f32x4 dv = *(const LAS f32x4*)(DEC + 16 * db + 4 * fq);
                  b16x8 ka; if (fq < 2) ka = *(const LAS b16x8*)(KH + (16 * db + fr) * HK_STR + 8 * fq); else ka = (b16x8){0, 0, 0, 0, 0, 0, 0, 0};
                  S[db] = __builtin_amdgcn_mfma_f32_16x16x32_bf16(ka, vb, S[db] * dv, 0, 0, 0); } }
            if (OUT) {
                float ss = (ot[0] * ot[0] + ot[1] * ot[1]) + (ot[2] * ot[2] + ot[3] * ot[3]);
                ss = col_sum(ss);
                if (fq == 0) RED[wave * 16 + fr] = ss;
                __syncthreads();
                float tots = 0.f;
#pragma unroll
                for (int w2 = 0; w2 < 8; ++w2) tots += RED[w2 * 16 + fr];
                const float rstd = rsqrtf(tots * (1.f / 128.f) + NORM_EPS);
                const size_t orow = row0 + 16 * step + fr; const int ecol = 16 * wave + 4 * fq;
                const f32x4 gn = *(const GAS f32x4*)(hg_norm + ecol);
                const h16x4 gh = *(const GAS h16x4*)((const h16*)(ws + WS_Y) + orow * DM + h * 128 + ecol);
                u32x2 w; w.x = pkh(ot[0] * rstd * gn[0] * (float)gh[0], ot[1] * rstd * gn[1] * (float)gh[1]); w.y = pkh(ot[2] * rstd * gn[2] * (float)gh[2], ot[3] * rstd * gn[3] * (float)gh[3]);
                *(GAS u32x2*)((h16*)(ws + WS_H) + orow * DM + h * 128 + ecol) = w;
            }
        }
        if (!OUT) {
#pragma unroll
            for (int db = 0; db < 8; ++db)
#pragma unroll
                for (int k = 0; k < 4; ++k) ST[(size_t)u * 16384 + (size_t)(16 * db + 4 * fq + k) * 128 + 16 * wave + fr] = S[db][k];
            if (part == 0) DT[(size_t)u * 128 + d] = __expf(dsum);
        }
        __syncthreads();
    }
}

struct Args { Ptrs p; int ph_lo, ph_hi; };
constexpr int N_PHASES = 1 + 4 * 13;
#define NOINL __device__ __forceinline__
typedef const pg8::bf16_t* cbp;
NOINL void site_ffn_in(LAS unsigned char* lds, unsigned char* ws, int widx, int G, int bx, int tid) { asm volatile("" : "+s"(ws));
    pg8::Gemm g{(cbp)(ws + WS_H), (cbp)(ws + WS_W + W_FI + (size_t)widx * W_FI_SZ), T, 2 * DFF, DM, tid}; pg8::StaticOrder S; S.init(T, 2 * DFF, G, bx);
    EpiSwiglu E{(h16*)(ws + WS_X + X_ACT)}; pg8::gemm_phase<EpiSwiglu, pg8::StaticOrder, true, true>(lds, g, S, E); }
NOINL void site_ffn_out(LAS unsigned char* lds, unsigned char* ws, int widx, int G, int bx, int tid) { asm volatile("" : "+s"(ws));
    pg8::Gemm g{(cbp)(ws + WS_X + X_ACT), (cbp)(ws + WS_W + W_FO + (size_t)widx * W_FO_SZ), T, DM, DFF, tid}; pg8::StaticOrder S; S.init(T, DM, G, bx);
    EpiPlain E{(h16*)(ws + WS_Y), DM}; pg8::gemm_phase<EpiPlain, pg8::StaticOrder, true, true>(lds, g, S, E); }
NOINL void site_thin(const float* xin, float* x, unsigned char* ws, const float* gpost, float alpha, const float* gpre, int G, int bx, int tid) { asm volatile("" : "+s"(ws)); asm volatile("" : "+v"(tid));
    const int vcu = (G % 8 == 0) ? (bx % 8) * (G / 8) + bx / 8 : bx;
    thin_phase(xin, x, (const h16*)(ws + WS_Y), gpost, alpha, gpre, (h16*)(ws + WS_H), vcu, G, __builtin_amdgcn_readfirstlane(tid >> 6), tid & 63); }
NOINL void site_nsa_in(LAS unsigned char* lds, unsigned char* ws, int G, int bx, int tid) { asm volatile("" : "+s"(ws));
    pg8::Gemm g{(cbp)(ws + WS_H), (cbp)(ws + WS_W + W_NI), T, NSA_NP, DM, tid}; pg8::StaticOrder S; S.init(T, NSA_NP, G, bx);
    EpiNsaIn E{ws + WS_X, (const float*)(ws + WS_ROPE_C), (const float*)(ws + WS_ROPE_S), (unsigned*)(ws + WS_CTL) + CW_KMAX}; pg8::gemm_phase<EpiNsaIn, pg8::StaticOrder, true, true>(lds, g, S, E); }
NOINL void site_cmp(LAS unsigned char* lds, unsigned char* ws, int G, int bx, int tid) { asm volatile("" : "+s"(ws)); asm volatile("" : "+v"(tid)); compress_phase(ws, lds, bx, G, tid); }
NOINL void site_attn(LAS unsigned char* lds, unsigned char* ws, int G, int bx, int tid) { asm volatile("" : "+s"(ws)); asm volatile("" : "+v"(tid)); attn_phase(ws, lds, bx, G, tid); }
NOINL void site_hg_in(LAS unsigned char* lds, unsigned char* ws, int G, int bx, int tid) { asm volatile("" : "+s"(ws));
    pg8::Gemm g{(cbp)(ws + WS_H), (cbp)(ws + WS_W + W_HI), T, 4096, DM, tid}; pg8::StaticOrder S; S.init(T, 4096, G, bx);
    EpiHgIn E{ws + WS_X, (h16*)(ws + WS_Y), (const float*)(ws + WS_MISC + 4096)}; pg8::gemm_phase<EpiHgIn, pg8::StaticOrder, true, true>(lds, g, S, E); }
NOINL void site_hg_a(LAS unsigned char* lds, unsigned char* ws, int G, int bx, int tid) { asm volatile("" : "+s"(ws)); asm volatile("" : "+v"(tid)); hgrn_phase<false>(ws, nullptr, lds, bx, G, tid); }
NOINL void site_hg_b(LAS unsigned char* lds, unsigned char* ws, const float* hg_norm, int G, int bx, int tid) { asm volatile("" : "+s"(ws)); asm volatile("" : "+v"(tid)); hgrn_phase<true>(ws, hg_norm, lds, bx, G, tid); }
NOINL void site_mix_out(LAS unsigned char* lds, unsigned char* ws, size_t woff, int G, int bx, int tid) { asm volatile("" : "+s"(ws));
    pg8::Gemm g{(cbp)(ws + WS_H), (cbp)(ws + WS_W + woff), T, DM, DM, tid}; pg8::StaticOrder S; S.init(T, DM, G, bx);
    EpiPlain E{(h16*)(ws + WS_Y), DM}; pg8::gemm_phase<EpiPlain, pg8::StaticOrder, true, true>(lds, g, S, E); }
NOINL void site_ple_pe(LAS unsigned char* lds, unsigned char* ws, int l, int G, int bx, int tid) { asm volatile("" : "+s"(ws));
    int kk = PLED; asm volatile("" : "+s"(kk));
    pg8::Gemm g{(cbp)(ws + WS_PH + (size_t)l * T * PLED * 2), (cbp)(ws + WS_W + W_PI + (size_t)l * W_PI_SZ), T, DM, kk, tid}; pg8::StaticOrder S; S.init(T, DM, G, bx);
    EpiPlain E{(h16*)(ws + WS_X + X_PE), DM}; pg8::gemm_phase<EpiPlain, pg8::StaticOrder, true, true>(lds, g, S, E); }
NOINL void site_ple_gate(LAS unsigned char* lds, unsigned char* ws, int l, int G, int bx, int tid) { asm volatile("" : "+s"(ws));
    pg8::Gemm g{(cbp)(ws + WS_H), (cbp)(ws + WS_W + W_PG + (size_t)l * W_SQ_SZ), T, DM, DM, tid}; pg8::StaticOrder S; S.init(T, DM, G, bx);
    EpiPleGate E{(const h16*)(ws + WS_X + X_PE), (h16*)(ws + WS_Y)}; pg8::gemm_phase<EpiPleGate, pg8::StaticOrder, true, true>(lds, g, S, E); }

DI int lane_id_now() { int x; asm volatile("v_mbcnt_lo_u32_b32 %0, -1, 0\n\tv_mbcnt_hi_u32_b32 %0, -1, %0" : "=v"(x)); return x; }
__global__ void __launch_bounds__(NTHREADS, 2) fwd_kernel(Args args) {
    extern __shared__ __attribute__((aligned(16))) unsigned char lds_raw[];
    LAS unsigned char* lds = (LAS unsigned char*)lds_raw;
    const int wave_s = __builtin_amdgcn_readfirstlane((int)threadIdx.x >> 6);
#define tid ((wave_s << 6) | lane_id_now())
    const int G = gridDim.x, bx = blockIdx.x;
    if ((int)threadIdx.x < 32) ((LAS unsigned*)(lds + LDSCTL_OFF))[threadIdx.x] = 0u;
    __syncthreads();
    unsigned char* ws = args.p.ws;
    XcdBarrier bar = xcd_barrier_post((unsigned*)(ws + WS_CTL) + CW_BAR, (volatile LAS unsigned*)(lds + LDSCTL_OFF));
    const int lo = args.ph_lo, hi = args.ph_hi;
    int ph = 0;
#ifndef ENMASK
#define ENMASK 0xFFFF
#endif
#define EN(j) ((ENMASK >> (j)) & 1)
#define RUN(k) ((k) >= lo && (k) < hi)
#define SEAM(k) do { if (RUN(k) && RUN((k) + 1)) { PROF_BEGIN(200); xcd_barrier(bar); PROF_END(200); } } while (0)
    PROF_BEGIN(99);
    if (EN(0) && RUN(0)) { const int vcu = (G % 8 == 0) ? (bx % 8) * (G / 8) + bx / 8 : bx; p0_prologue(args.p, lds, vcu, G, __builtin_amdgcn_readfirstlane(tid >> 6), tid & 63); }
    PROF_END(99);
    SEAM(0);
#pragma unroll 1
    for (int hs = 0; hs < 2 * DEPTH; ++hs) {
        const int l = hs >> 1, second = hs & 1, base = 1 + hs * 13;
        const float* ng = args.p.ng + (size_t)l * 8 * DM;
        ph = base + 0; PROF_BEGIN(100); if (EN(1) && RUN(ph)) { site_ffn_in(lds, ws, 2 * l + second, G, bx, tid);
#ifdef DUP_FFNIN
 __syncthreads(); site_ffn_in(lds, ws, 2 * l + second, G, bx, tid);
#endif
 } PROF_END(ph - base + 100); SEAM(ph);
        ph = base + 1; PROF_BEGIN(101); if (EN(2) && RUN(ph)) site_ffn_out(lds, ws, 2 * l + second, G, bx, tid); PROF_END(ph - base + 100); SEAM(ph);
        ph = base + 2; PROF_BEGIN(102); if (EN(3) && RUN(ph)) site_thin(hs == 0 ? args.p.x : args.p.out, args.p.out, ws, ng + (second ? 5 : 1) * DM, 0.5f, ng + (second ? 6 : 2) * DM, G, bx, tid); PROF_END(ph - base + 100); SEAM(ph);
        if (!second) {
            if (l == 0) {
                ph = base + 3; PROF_BEGIN(103); if (EN(4) && RUN(ph)) site_nsa_in(lds, ws, G, bx, tid); PROF_END(ph - base + 100); SEAM(ph);
                ph = base + 4; PROF_BEGIN(104); if (EN(5) && RUN(ph)) { site_cmp(lds, ws, G, bx, tid);
#ifdef DUP_CMP
 __syncthreads(); site_cmp(lds, ws, G, bx, tid);
#endif
 } PROF_END(ph - base + 100); SEAM(ph);
                ph = base + 5; PROF_BEGIN(105); if (EN(6) && RUN(ph)) { site_attn(lds, ws, G, bx, tid);
#ifdef DUP_ATT
 __syncthreads(); site_attn(lds, ws, G, bx, tid);
#endif
 } PROF_END(ph - base + 100); SEAM(ph);
            } else {
                ph = base + 6; PROF_BEGIN(106); if (EN(7) && RUN(ph)) site_hg_in(lds, ws, G, bx, tid); PROF_END(ph - base + 100); SEAM(ph);
                ph = base + 7; PROF_BEGIN(107); if (EN(8) && RUN(ph)) { site_hg_a(lds, ws, G, bx, tid);
#ifdef DUP_HGA
 __syncthreads(); site_hg_a(lds, ws, G, bx, tid);
#endif
 } PROF_END(ph - base + 100); SEAM(ph);
                ph = base + 8; PROF_BEGIN(108); if (EN(9) && RUN(ph)) { site_hg_b(lds, ws, args.p.hg_norm, G, bx, tid);
#ifdef DUP_HGB
 __syncthreads(); site_hg_b(lds, ws, args.p.hg_norm, G, bx, tid);
#endif
 } PROF_END(ph - base + 100); SEAM(ph);
            }
            ph = base + 9; PROF_BEGIN(109); if (EN(10) && RUN(ph)) site_mix_out(lds, ws, l == 0 ? W_NO : W_HO, G, bx, tid); PROF_END(ph - base + 100); SEAM(ph);
            ph = base + 10; PROF_BEGIN(110); if (EN(11) && RUN(ph)) site_thin(args.p.out, args.p.out, ws, ng + 3 * DM, 1.0f, ng + 4 * DM, G, bx, tid); PROF_END(ph - base + 100); SEAM(ph);
        } else {
            ph = base + 11; PROF_BEGIN(111); if (EN(12) && RUN(ph)) {
#ifndef NO_PE
 site_ple_pe(lds, ws, l, G, bx, tid);
#endif
 asm volatile("s_waitcnt vmcnt(0)" ::: "memory"); __syncthreads();
#ifndef NO_GATE
 site_ple_gate(lds, ws, l, G, bx, tid);
#endif
 } PROF_END(ph - base + 100); SEAM(ph);
            ph = base + 12; PROF_BEGIN(112); if (EN(13) && RUN(ph)) site_thin(args.p.out, args.p.out, ws, ng + 7 * DM, 1.0f, (l + 1 < DEPTH) ? args.p.ng + (size_t)(l + 1) * 8 * DM : nullptr, G, bx, tid); PROF_END(ph - base + 100); SEAM(ph);
        }
    }
#ifdef PROF
    xcd_barrier(bar);
    if (threadIdx.x == 0) { const float tt = (float)*(LAS unsigned long long*)(lds + PROF_ACC);
#ifdef PROF_MIN
        args.p.out[bx] += 200000.0f / fmaxf(tt, 1.f);
#else
        args.p.out[bx] += tt * (1.0f / 20000.0f);
#endif
    }
#endif
#undef RUN
#undef SEAM
#undef tid
}

#ifndef MK_PER_PHASE
#define MK_PER_PHASE 0
#endif
extern "C" void kernel_launch(void* const* d_in, const int* in_sizes, int n_in, void* d_out, int out_size, void* d_ws, size_t ws_size, hipStream_t stream) {
    static int grid = 0;
    if (grid == 0) {
        if (n_in != 16 || in_sizes[0] != T * DM || out_size != T * DM || ws_size < WS_END) { fprintf(stderr, "kernel_launch: unexpected shapes / workspace (%d inputs, ws %zu)\n", n_in, ws_size); grid = -1; return; }
        int dev = 0, cus = 0, per_cu = 0;
        if (hipGetDevice(&dev) != hipSuccess || hipDeviceGetAttribute(&cus, hipDeviceAttributeMultiprocessorCount, dev) != hipSuccess) { grid = -1; return; }
        if (hipFuncSetAttribute((const void*)fwd_kernel, hipFuncAttributeMaxDynamicSharedMemorySize, LDS_BYTES) != hipSuccess) { grid = -1; return; }
        if (hipOccupancyMaxActiveBlocksPerMultiprocessor(&per_cu, (const void*)fwd_kernel, NTHREADS, LDS_BYTES) != hipSuccess || per_cu < 1) { fprintf(stderr, "kernel_launch: occupancy query says %d\n", per_cu); }
        (void)hipGetLastError();
        grid = cus;
    }
    if (grid < 0) return;
    if (hipMemsetAsync((char*)d_ws + WS_CTL, 0, CTL_ZERO_BYTES, stream) != hipSuccess) return;
    Args a{};
    const float* const* in = (const float* const*)d_in;
    a.p.x = in[0]; a.p.p = in[1]; a.p.ng = in[2]; a.p.ffn_in = in[3]; a.p.ffn_out = in[4]; a.p.ple_in = in[5]; a.p.ple_gate = in[6]; a.p.nsa_in = in[7]; a.p.nsa_out = in[8];
    a.p.cmp_pos = in[9]; a.p.cmp_w1 = in[10]; a.p.cmp_w2 = in[11]; a.p.hg_in = in[12]; a.p.hg_out = in[13]; a.p.hg_norm = in[14]; a.p.hg_lb = in[15];
    a.p.out = (float*)d_out; a.p.ws = (unsigned char*)d_ws;
#if MK_PER_PHASE
    for (int k = 0; k < N_PHASES; ++k) { a.ph_lo = k; a.ph_hi = k + 1; hipLaunchKernelGGL(fwd_kernel, dim3(grid), dim3(NTHREADS), LDS_BYTES, stream, a); }
#else
    a.ph_lo = 0; a.ph_hi = N_PHASES;
    hipLaunchKernelGGL(fwd_kernel, dim3(grid), dim3(NTHREADS), LDS_BYTES, stream, a);
#endif
}
```

```cpp
#include <hip/hip_runtime.h>
#include <cstdio>
#include <cstdint>
#include <cmath>
namespace pg8 {
#define PG8_LAS __attribute__((address_space(3)))
typedef unsigned short bf16_t;
typedef _Float16 bf16x8 __attribute__((ext_vector_type(8)));
typedef float f32x4 __attribute__((ext_vector_type(4)));
typedef unsigned u32x4 __attribute__((ext_vector_type(4)));
constexpr int BM = 256, BK = 64, HALF = 128, HTB = HALF * BK * 2  , STAGE_BYTES = 8 * HTB, NXCD = 8, WGM = 8;

__host__ __device__ __forceinline__ int lds_byte(int r, int c) { const int st = (r >> 4) * 2 + (c >> 5), rr = r & 15, cc = c & 31, ob = rr * 64 + cc * 2; return st * 1024 + (ob ^ (((ob >> 9) & 1) << 5)); }
__host__ __device__ __forceinline__ void stage_rc(int b, int& R, int& C) { const int st = b / 1024, sb = b % 1024, swz = sb ^ (((sb >> 9) & 1) << 5); R = (st >> 1) * 16 + swz / 64; C = (st & 1) * 32 + (swz % 64) / 2; }
__host__ __device__ __forceinline__ int perm32(int rho) { const int n = rho >> 4, i = rho & 15; return 8 * (i >> 2) + 4 * n + (i & 3); }

struct Unit { int pm, pn; };
struct Gemm { const bf16_t* A; const bf16_t* Bt; int M, N, K; int tid; };

struct StaticOrder {
    int nM, nN, nwg, G, c;
    __host__ __device__ void init(int M, int N, int G_, int c_) { nM = M / BM; nN = N / BM; nwg = nM * nN; G = G_; c = c_; }
    __host__ __device__ bool next(int i, Unit& u) const {
        const long L = (long)i * G + c; if (L >= nwg) return false;
        int wgid = (int)L; { const int q = nwg / NXCD, r = nwg % NXCD, xcd = wgid % NXCD, off = wgid / NXCD; wgid = (xcd < r ? xcd * (q + 1) : r * (q + 1) + (xcd - r) * q) + off; }
        const int nig = WGM * nN, gid = wgid / nig, fm = gid * WGM, gsz = (nM - fm) < WGM ? (nM - fm) : WGM;
        u.pm = fm + ((wgid % nig) % gsz); u.pn = (wgid % nig) / gsz; return true;
    }
    __device__ __forceinline__ void a_ready(const Unit&) const {}
    __device__ __forceinline__ void done(const Unit&) const {}
};

template <class Epi, class Sched, bool ALIGN_EPI = false, bool SP2 = false>
__device__ __forceinline__ void gemm_phase(PG8_LAS unsigned char* lds, const Gemm g, const Sched& S, const Epi& E) {
    int tid_l = g.tid; asm volatile("" : "+v"(tid_l));
    const int tid = tid_l, wid = __builtin_amdgcn_readfirstlane(tid >> 6), lane = tid & 63, wr = wid >> 2, wc = wid & 3, fr = lane & 15, fq = lane >> 4;
    const int K = g.K, nt = K / BK;
    unsigned voffA[2], voffB[2];
#pragma unroll
    for (int i = 0; i < 2; ++i) { int R, C; stage_rc(tid * 16 + i * 8192, R, C); const int Rb = Epi::PERM ? ((R & ~31) + perm32(R & 31)) : R;
        voffA[i] = (unsigned)(R * K + C) * 2u; voffB[i] = (unsigned)(Rb * K + C) * 2u; }
    const size_t kstep = (size_t)(BK * 2);
    const size_t hstep = (size_t)HALF * K * 2;
    const size_t tstep = 2 * hstep;
    const unsigned ldsw = (unsigned)wid * 1024u;
    const int aoff = lds_byte(wr * 64 + fr, fq * 8), boff = lds_byte(wc * 32 + fr, fq * 8);
#define PG8_SA(b, h) (((b) * 2 + (h)) * HTB)
#define PG8_SB(b, h) ((4 + (b) * 2 + (h)) * HTB)
#define PG8_STAGE(bufoff, gbase, voff) do { _Pragma("unroll") for (int _i = 0; _i < 2; ++_i) \
        __builtin_amdgcn_global_load_lds((const unsigned*)((const char*)(gbase) + (voff)[_i]), (PG8_LAS unsigned*)(lds + (bufoff) + ldsw + _i * 8192), 16, 0, 0); } while (0)
#define PG8_LDA(dst, b, h) do { _Pragma("unroll") for (int m = 0; m < 4; ++m) _Pragma("unroll") for (int k = 0; k < 2; ++k) dst[m][k] = *(const PG8_LAS bf16x8*)(lds + PG8_SA(b, h) + aoff + m * 2048 + k * 1024); } while (0)
#define PG8_LDB(dst, b, h) do { _Pragma("unroll") for (int n = 0; n < 2; ++n) _Pragma("unroll") for (int k = 0; k < 2; ++k) dst[n][k] = *(const PG8_LAS bf16x8*)(lds + PG8_SB(b, h) + boff + n * 2048 + k * 1024); } while (0)
#define PG8_MMA(ai, bj, At, Bt) do { __builtin_amdgcn_s_setprio(1); _Pragma("unroll") for (int m = 0; m < 4; ++m) _Pragma("unroll") for (int n = 0; n < 2; ++n) _Pragma("unroll") for (int k = 0; k < 2; ++k) \
        acc[ai][bj][m][n] = __builtin_amdgcn_mfma_f32_16x16x32_f16(Bt[n][k], At[m][k], acc[ai][bj][m][n], 0, 0, 0); __builtin_amdgcn_s_setprio(0); } while (0)
#define PG8_WAIT_V(n) asm volatile("s_waitcnt vmcnt(" #n ")" ::: "memory")
#define PG8_WAIT_L(n) asm volatile("s_waitcnt lgkmcnt(" #n ")" ::: "memory")
#define PG8_BAR __builtin_amdgcn_s_barrier()
#define PG8_SCHED __builtin_amdgcn_sched_barrier(0)
    Unit cur, nxt; int ui = 0;
    if (!S.next(0, cur)) return;
    f32x4 acc[2][2][4][2];
#pragma unroll
    for (int a = 0; a < 2; ++a)
#pragma unroll
        for (int b = 0; b < 2; ++b)
#pragma unroll
            for (int m = 0; m < 4; ++m)
#pragma unroll
                for (int n = 0; n < 2; ++n) acc[a][b][m][n] = (f32x4){0.f, 0.f, 0.f, 0.f};
    bf16x8 At[4][2], B0[2][2], B1[2][2];
    const char* cA = (const char*)g.A + (size_t)cur.pm * tstep; const char* cB = (const char*)g.Bt + (size_t)cur.pn * tstep;
    S.a_ready(cur);
    if constexpr (SP2) {
        PG8_STAGE(PG8_SB(0, 0), cB, voffB); PG8_STAGE(PG8_SB(0, 1), cB + hstep, voffB); PG8_STAGE(PG8_SA(0, 0), cA, voffA); PG8_STAGE(PG8_SA(0, 1), cA + hstep, voffA);
        if (wr == 1) PG8_BAR;
        PG8_WAIT_V(2); PG8_BAR;
        PG8_STAGE(PG8_SB(1, 0), cB + kstep, voffB); PG8_STAGE(PG8_SA(1, 0), cA + kstep, voffA); PG8_STAGE(PG8_SB(1, 1), cB + hstep + kstep, voffB);
        PG8_WAIT_V(6); PG8_BAR;
    } else {
        PG8_STAGE(PG8_SB(0, 0), cB, voffB); PG8_STAGE(PG8_SA(0, 0), cA, voffA); PG8_STAGE(PG8_SB(0, 1), cB + hstep, voffB); PG8_STAGE(PG8_SA(0, 1), cA + hstep, voffA);
        if (wr == 1) PG8_BAR;
        PG8_WAIT_V(4); PG8_BAR;
        PG8_STAGE(PG8_SB(1, 0), cB + kstep, voffB); PG8_STAGE(PG8_SA(1, 0), cA + kstep, voffA); PG8_STAGE(PG8_SB(1, 1), cB + hstep + kstep, voffB);
        PG8_WAIT_V(6); PG8_BAR;
    }
    for (;;) {
        const bool has_next = S.next(ui + 1, nxt);
        const char* nA = has_next ? (const char*)g.A + (size_t)nxt.pm * tstep : cA; const char* nB = has_next ? (const char*)g.Bt + (size_t)nxt.pn * tstep : cB;
        for (int t = 0; t < nt; t += 2) {
            const bool last = (t == nt - 2);
            const char* a1 = cA + (size_t)(t + 1) * kstep;
            const char* a2 = last ? nA : cA + (size_t)(t + 2) * kstep; const char* b2 = last ? nB : cB + (size_t)(t + 2) * kstep;
            const char* a3 = a2 + kstep; const char* b3 = b2 + kstep;
            if (last && has_next) S.a_ready(nxt);
            if constexpr (SP2) {
            PG8_LDB(B0, 0, 0); PG8_LDB(B1, 0, 1); PG8_SCHED; PG8_LDA(At, 0, 0); PG8_STAGE(PG8_SA(1, 1), a1 + hstep, voffA);
            PG8_WAIT_V(8); PG8_WAIT_L(0); PG8_BAR; PG8_MMA(0, 0, At, B0); PG8_MMA(0, 1, At, B1); PG8_BAR; PG8_SCHED;
            PG8_LDA(At, 0, 1); PG8_STAGE(PG8_SB(0, 0), b2, voffB); PG8_STAGE(PG8_SB(0, 1), b2 + hstep, voffB); PG8_STAGE(PG8_SA(0, 0), a2, voffA);
            PG8_WAIT_V(8); PG8_WAIT_L(0); PG8_BAR; PG8_MMA(1, 0, At, B0); PG8_MMA(1, 1, At, B1); PG8_BAR; PG8_SCHED;
            PG8_LDB(B0, 1, 0); PG8_LDB(B1, 1, 1); PG8_SCHED; PG8_LDA(At, 1, 0); PG8_STAGE(PG8_SA(0, 1), a2 + hstep, voffA);
            PG8_WAIT_V(8); PG8_WAIT_L(0); PG8_BAR; PG8_MMA(0, 0, At, B0); PG8_MMA(0, 1, At, B1); PG8_BAR; PG8_SCHED;
            PG8_LDA(At, 1, 1); PG8_STAGE(PG8_SB(1, 0), b3, voffB); PG8_STAGE(PG8_SB(1, 1), b3 + hstep, voffB); PG8_STAGE(PG8_SA(1, 0), a3, voffA);
            PG8_WAIT_V(8); PG8_WAIT_L(0); PG8_BAR; PG8_MMA(1, 0, At, B0); PG8_MMA(1, 1, At, B1); PG8_BAR; PG8_SCHED;
            } else {
            PG8_LDB(B0, 0, 0); PG8_SCHED; PG8_LDA(At, 0, 0); PG8_STAGE(PG8_SA(1, 1), a1 + hstep, voffA);
            PG8_WAIT_L(8); PG8_BAR; PG8_WAIT_L(0); PG8_MMA(0, 0, At, B0); PG8_BAR; PG8_SCHED;
            PG8_LDB(B1, 0, 1); PG8_STAGE(PG8_SB(0, 0), b2, voffB);
            PG8_BAR; PG8_WAIT_L(0); PG8_MMA(0, 1, At, B1); PG8_BAR;
            PG8_LDA(At, 0, 1); PG8_STAGE(PG8_SA(0, 0), a2, voffA);
            PG8_BAR; PG8_WAIT_L(0); PG8_MMA(1, 0, At, B0); PG8_BAR; PG8_SCHED;
            PG8_STAGE(PG8_SB(0, 1), b2 + hstep, voffB);
            PG8_WAIT_V(6); PG8_BAR; PG8_MMA(1, 1, At, B1); PG8_BAR;
            PG8_LDB(B0, 1, 0); PG8_SCHED; PG8_LDA(At, 1, 0); PG8_STAGE(PG8_SA(0, 1), a2 + hstep, voffA);
            PG8_WAIT_L(8); PG8_BAR; PG8_WAIT_L(0); PG8_MMA(0, 0, At, B0); PG8_BAR; PG8_SCHED;
            PG8_LDB(B1, 1, 1); PG8_STAGE(PG8_SB(1, 0), b3, voffB);
            PG8_BAR; PG8_WAIT_L(0); PG8_MMA(0, 1, At, B1); PG8_BAR;
            PG8_LDA(At, 1, 1); PG8_STAGE(PG8_SA(1, 0), a3, voffA);
            PG8_BAR; PG8_WAIT_L(0); PG8_MMA(1, 0, At, B0); PG8_BAR; PG8_SCHED;
            PG8_STAGE(PG8_SB(1, 1), b3 + hstep, voffB);
            PG8_WAIT_V(6); PG8_BAR; PG8_MMA(1, 1, At, B1); PG8_BAR;
            }
        }
        if constexpr (ALIGN_EPI) { if (wr == 0) PG8_BAR; }
        if constexpr (!Epi::AFTER_DRAIN) { E(acc, cur, wr, wc, fr, fq); S.done(cur); }
        if (!has_next) break;
#pragma unroll
        for (int a = 0; a < 2; ++a)
#pragma unroll
            for (int b = 0; b < 2; ++b)
#pragma unroll
                for (int m = 0; m < 4; ++m)
#pragma unroll
                    for (int n = 0; n < 2; ++n) acc[a][b][m][n] = (f32x4){0.f, 0.f, 0.f, 0.f};
        cur = nxt; cA = nA; cB = nB; ++ui;
        if constexpr (ALIGN_EPI) { if (wr == 1) PG8_BAR; }
    }
    PG8_WAIT_V(0);
    if constexpr (!ALIGN_EPI) { if (wr == 0) PG8_BAR; }
    PG8_BAR;
    if constexpr (Epi::AFTER_DRAIN) { E.fused(acc, cur, wr, wc, fr, fq, lds, wid, lane); S.done(cur); }
#undef PG8_SA
#undef PG8_SB
#undef PG8_STAGE
#undef PG8_LDA
#undef PG8_LDB
#undef PG8_MMA
#undef PG8_WAIT_V
#undef PG8_WAIT_L
#undef PG8_BAR
#undef PG8_SCHED
}
}

#define GAS __attribute__((address_space(1)))
#define LAS __attribute__((address_space(3)))
#define XB_TMO      128
#define XB_XCNT(j)  (256  + 64 * (j))
#define XB_XSUB(j)  (1280 + 64 * (j))
#define XB_XGEN(j)  (2304 + 64 * (j))
#define XB_TOP      3328
#define XB_TOPGEN   3392
#define XCD_BAR_WORDS 3456
#define XB_SPIN_CAP (1u << 18)

__device__ __forceinline__ unsigned xb_ld(unsigned* p)              { return __hip_atomic_load(p, __ATOMIC_RELAXED, __HIP_MEMORY_SCOPE_AGENT); }
__device__ __forceinline__ unsigned xb_add(unsigned* p, unsigned v) { return __hip_atomic_fetch_add(p, v, __ATOMIC_RELAXED, __HIP_MEMORY_SCOPE_AGENT); }
__device__ __forceinline__ unsigned xb_xcc_id() { return (unsigned)__builtin_amdgcn_s_getreg((3 << 11) | 20) & 0xFu; }
#define XB_SPIN(cond, bar) do { unsigned _sp = 0; while (cond) { __builtin_amdgcn_s_sleep(1); \
    if ((++_sp & 255u) == 0u) { if (xb_ld(&(bar)[XB_TMO])) break; if (_sp > XB_SPIN_CAP) { atomicAdd(&(bar)[XB_TMO], 1u); break; } } } } while (0)

struct XcdBarrier {
    unsigned* bar; unsigned x;
    volatile LAS unsigned* st;
};

__device__ __forceinline__ XcdBarrier xcd_barrier_post(unsigned* bar, volatile LAS unsigned* st) {
    XcdBarrier b; b.bar = bar; b.x = xb_xcc_id(); b.st = st;
    if (threadIdx.x == 0) (void)xb_add(&bar[XB_XCNT(b.x)], 1u);
    return b;
}
__device__ __forceinline__ void xcd_barrier_complete(unsigned* bar, unsigned x, unsigned& nloc, unsigned& nx) {
    const unsigned G = gridDim.x * gridDim.y * gridDim.z;
    unsigned sum, cnt, mine, sp = 0u;
    for (;;) {
        sum = 0u; cnt = 0u; mine = 0u;
#pragma unroll
        for (unsigned j = 0; j < 16; ++j) { const unsigned c = xb_ld(&bar[XB_XCNT(j)]); sum += c; cnt += (c > 0u) ? 1u : 0u; mine = (j == x) ? c : mine; }
        if (sum == G) break;
        __builtin_amdgcn_s_sleep(1);
        if ((++sp & 255u) == 0u) { if (xb_ld(&bar[XB_TMO])) break; if (sp > XB_SPIN_CAP) { atomicAdd(&bar[XB_TMO], 1u); break; } }
    }
    nloc = mine > 0u ? mine : 1u; nx = cnt > 0u ? cnt : 1u;
}

__device__ __forceinline__ void xcd_barrier(const XcdBarrier& b) {
    asm volatile("s_waitcnt vmcnt(0)" ::: "memory");
    __syncthreads();
    if (threadIdx.x == 0) {
        unsigned* bar = b.bar;
        __builtin_amdgcn_s_waitcnt(0);
        unsigned nloc = b.st[0], nx = b.st[1];
        if (nloc == 0u) { xcd_barrier_complete(bar, b.x, nloc, nx); b.st[0] = nloc; b.st[1] = nx; }
        const unsigned old = xb_add(&bar[XB_XSUB(b.x)], 1u);
        const unsigned gen = old / nloc;
        if (old + 1u == (gen + 1u) * nloc) {
            __builtin_amdgcn_fence(__ATOMIC_RELEASE, "agent");
            asm volatile("s_waitcnt vmcnt(0)" ::: "memory");
            const unsigned og = xb_add(&bar[XB_TOP], 1u);
            const unsigned tg = og / nx;
            if (og + 1u == (tg + 1u) * nx) xb_add(&bar[XB_TOPGEN], 1u);
            else XB_SPIN(xb_ld(&bar[XB_TOPGEN]) == tg, bar);
            __builtin_amdgcn_fence(__ATOMIC_ACQUIRE, "agent");
            xb_add(&bar[XB_XGEN(b.x)], 1u);
            asm volatile("s_waitcnt vmcnt(0)" ::: "memory");
        } else {
            XB_SPIN(xb_ld(&bar[XB_XGEN(b.x)]) == gen, bar);
            __builtin_amdgcn_fence(__ATOMIC_ACQUIRE, "agent");
            asm volatile("s_waitcnt vmcnt(0)" ::: "memory");
        }
    }
    __syncthreads();
}


constexpr int BATCH = 2, SEQ = 16384, DM = 1024, T = BATCH * SEQ, DFF = 2816, PLED = 256, DEPTH = 2;
constexpr int NH = 16, NG = 4, HD = 64, NSA_IN = 2608, NSA_NP = 2816;
constexpr int NCMP = 1023, NCMP_P = 1024;
constexpr int HG_H = 8, HG_D = 128;
constexpr float NORM_EPS = 1e-6f;
constexpr float LOG2E = 1.4426950408889634f;
constexpr int NWAVES = 8, NTHREADS = 512;

constexpr size_t MiB = 1u << 20;
constexpr size_t WS_CTL = 0, CTL_ZERO_BYTES = 1 * MiB;
constexpr size_t WS_ROPE_C = 1 * MiB, WS_ROPE_S = 3 * MiB;
constexpr size_t WS_MISC = 5 * MiB;
constexpr size_t WS_W = 6 * MiB;
constexpr size_t W_FI = 0;
constexpr size_t W_FI_SZ = (size_t)2 * DFF * DM * 2;
constexpr size_t W_FO = W_FI + 4 * W_FI_SZ;
constexpr size_t W_FO_SZ = (size_t)DM * DFF * 2;
constexpr size_t W_PI = W_FO + 4 * W_FO_SZ;
constexpr size_t W_PI_SZ = (size_t)DM * PLED * 2;
constexpr size_t W_PG = W_PI + 2 * W_PI_SZ;
constexpr size_t W_SQ_SZ = (size_t)DM * DM * 2;
constexpr size_t W_NI = W_PG + 2 * W_SQ_SZ;
constexpr size_t W_NI_SZ = (size_t)NSA_NP * DM * 2;
constexpr size_t W_NO = W_NI + W_NI_SZ;
constexpr size_t W_HI = W_NO + W_SQ_SZ;
constexpr size_t W_HI_SZ = (size_t)4096 * DM * 2;
constexpr size_t W_HO = W_HI + W_HI_SZ;
constexpr size_t W_C1 = W_HO + W_SQ_SZ;
constexpr size_t W_C1_SZ = (size_t)64 * 2048 * 2;
constexpr size_t W_C2 = W_C1 + 2 * W_C1_SZ;
constexpr size_t W_C2_SZ = (size_t)64 * 64 * 2;
constexpr size_t W_END = W_C2 + 2 * W_C2_SZ;
static_assert(W_END <= 96 * MiB, "weights region");
constexpr size_t WS_PH = 102 * MiB;
constexpr size_t WS_H = 134 * MiB;
constexpr size_t WS_Y = 198 * MiB;
constexpr size_t WS_X = 262 * MiB;
constexpr size_t X_ACT = 0;
constexpr size_t X_Q = 0, X_KC = 64 * MiB, X_VC = 80 * MiB, X_KS = 96 * MiB, X_VS = 112 * MiB, X_KW = 128 * MiB, X_VW = 144 * MiB;
constexpr size_t X_GATES = 160 * MiB, X_KCMP = 168 * MiB, X_VCMP = 169 * MiB, X_OSCR = 170 * MiB;
constexpr size_t X_QH = 0, X_LF = 64 * MiB, X_VH = 128 * MiB, X_ST = 192 * MiB, X_DT = 208 * MiB;
constexpr size_t X_PE = 0;
constexpr size_t WS_END = 471 * MiB;
constexpr int CW_BAR = 4096, CW_SS = 32768, CW_KMAX = 2048;

constexpr int RING_BYTES = 131072;
constexpr int LDSCTL_OFF = RING_BYTES;
constexpr int LDS_BYTES = 147456;

#ifdef PROF
#define PROF_T0 (LDSCTL_OFF + 64)
#define PROF_ACC (LDSCTL_OFF + 72)
#define PROF_BEGIN(id) do { if ((id) == PROF && threadIdx.x == 0) *(LAS unsigned long long*)(lds + PROF_T0) = __builtin_amdgcn_s_memrealtime(); } while (0)
#define PROF_END(id) do { if ((id) == PROF && threadIdx.x == 0) { *(LAS unsigned long long*)(lds + PROF_ACC) += __builtin_amdgcn_s_memrealtime() - *(LAS unsigned long long*)(lds + PROF_T0); } } while (0)
#else
#define PROF_BEGIN(id) do { } while (0)
#define PROF_END(id) do { } while (0)
#endif

typedef _Float16 h16;
typedef _Float16 h16x8 __attribute__((ext_vector_type(8)));
typedef _Float16 h16x4 __attribute__((ext_vector_type(4)));
typedef _Float16 h16x2 __attribute__((ext_vector_type(2)));
typedef __bf16 b16x8 __attribute__((ext_vector_type(8)));
typedef __bf16 b16x4 __attribute__((ext_vector_type(4)));
typedef float f32x4 __attribute__((ext_vector_type(4)));
typedef float f32x2 __attribute__((ext_vector_type(2)));
typedef unsigned u32x4 __attribute__((ext_vector_type(4)));
typedef unsigned u32x2 __attribute__((ext_vector_type(2)));
typedef short s16x4 __attribute__((ext_vector_type(4)));
typedef short s16x8 __attribute__((ext_vector_type(8)));

#define DI __device__ __forceinline__
#define LDS_WAIT() asm volatile("s_waitcnt lgkmcnt(0)" ::: "memory")

DI float wave_sum(float v) {
#pragma unroll
    for (int o = 1; o < 64; o <<= 1) v += __shfl_xor(v, o);
    return v;
}
DI float sigmoidf_(float x) { return __builtin_amdgcn_rcpf(1.0f + __expf(-x)); }
DI float siluf_(float x) { return x * __builtin_amdgcn_rcpf(1.0f + __expf(-x)); }
DI unsigned pkh(float a, float b) { h16x2 v = {(h16)a, (h16)b}; return __builtin_bit_cast(unsigned, v); }
DI u32x4 pkh8(f32x4 a, f32x4 b) { u32x4 w; w.x = pkh(a[0], a[1]); w.y = pkh(a[2], a[3]); w.z = pkh(b[0], b[1]); w.w = pkh(b[2], b[3]); return w; }
DI unsigned pkb(float a, float b) { typedef __bf16 b2 __attribute__((ext_vector_type(2))); f32x2 f = {a, b}; b2 v = __builtin_convertvector(f, b2); return __builtin_bit_cast(unsigned, v); }

struct Ptrs {
    const float *x, *p, *ng, *ffn_in, *ffn_out, *ple_in, *ple_gate, *nsa_in, *nsa_out, *cmp_pos, *cmp_w1, *cmp_w2, *hg_in, *hg_out, *hg_norm, *hg_lb;
    float* out; unsigned char* ws;
};

DI void transpose_item(const float* W, int ldw, int K, h16* WT, int dstrow0, int srccol0, int nvalid, int k0, LAS float* scr, int lane) {
    const int nn = lane & 31;
#pragma unroll 8
    for (int i = 0; i < 32; ++i) { const int kk = 2 * i + (lane >> 5); scr[kk * 33 + nn] = (nn < nvalid) ? W[(size_t)(k0 + kk) * ldw + srccol0 + nn] : 0.f; }
    LDS_WAIT(); asm volatile("" ::: "memory");
    const int c = lane & 7;
#pragma unroll
    for (int j = 0; j < 4; ++j) { const int n = (lane >> 3) + 8 * j; const LAS float* s = scr + (8 * c) * 33 + n;
        u32x4 o; o.x = pkh(s[0 * 33], s[1 * 33]); o.y = pkh(s[2 * 33], s[3 * 33]); o.z = pkh(s[4 * 33], s[5 * 33]); o.w = pkh(s[6 * 33], s[7 * 33]);
        *(GAS u32x4*)(WT + (size_t)(dstrow0 + n) * K + k0 + 8 * c) = o; }
    LDS_WAIT(); asm volatile("" ::: "memory");
}
template <int MAP> DI bool conv_matrix(int& it, const float* W, int ldw, int K, int NR, h16* WT, LAS float* scr, int lane) {
    const int nrb = NR / 32, nitems = (K / 64) * nrb;
    if (it >= nitems) { it -= nitems; return false; }
    const int kb = it / nrb, rb = it % nrb, c0 = 32 * rb;
    int src = c0, nvalid = 32;
    if (MAP == 1) { const int pn = c0 >> 8, bj = (c0 >> 7) & 1, j0 = c0 & 127; src = bj * DFF + 128 * pn + j0; }
    if (MAP == 2) { const int pn = c0 >> 8, bj = (c0 >> 7) & 1, hl = (c0 & 127) >> 5;
        if (pn < 4) src = (4 * pn + hl) * 64 + 32 * bj;
        else if (pn < 10) src = 1024 + (pn - 4) * 256 + hl * 64 + 32 * bj;
        else { const int jj = c0 & 255; src = 2560 + jj; nvalid = 48 - jj; nvalid = nvalid < 0 ? 0 : (nvalid > 32 ? 32 : nvalid); if (nvalid == 0) src = 0; } }
    transpose_item(W, ldw, K, WT, c0, src, nvalid, 64 * kb, scr, lane);
    return true;
}
DI void rms_row_to_h16(const float* xrow, const float* gain, h16* orow, float* xcopy, int lane) {
    const GAS f32x4* xr = (const GAS f32x4*)xrow; const GAS f32x4* gr = (const GAS f32x4*)gain;
    f32x4 v[4]; float s = 0.f;
#pragma unroll
    for (int j = 0; j < 2; ++j) { v[2 * j] = xr[2 * lane + 128 * j]; v[2 * j + 1] = xr[2 * lane + 1 + 128 * j]; }
#pragma unroll
    for (int j = 0; j < 4; ++j) s += (v[j].x * v[j].x + v[j].y * v[j].y) + (v[j].z * v[j].z + v[j].w * v[j].w);
    const float r = rsqrtf(wave_sum(s) * (1.f / DM) + NORM_EPS);
#pragma unroll
    for (int j = 0; j < 2; ++j) {
        if (xcopy) { ((GAS f32x4*)xcopy)[2 * lane + 128 * j] = v[2 * j]; ((GAS f32x4*)xcopy)[2 * lane + 1 + 128 * j] = v[2 * j + 1]; }
        const f32x4 g0 = gr[2 * lane + 128 * j], g1 = gr[2 * lane + 1 + 128 * j];
        *(GAS u32x4*)(orow + 8 * lane + 512 * j) = pkh8(v[2 * j] * r * g0, v[2 * j + 1] * r * g1); }
}
DI void p0_prologue(const Ptrs& P, LAS unsigned char* lds, int vcu, int G, int wave, int lane) {
    LAS float* scr = (LAS float*)(lds + wave * 16384);
    const int gw = vcu * NWAVES + wave, NGW = G * NWAVES;
    unsigned char* wb = P.ws + WS_W;
    constexpr int I_FI = 16 * 176, I_FO = 44 * 32, I_PI = 4 * 32, I_SQ = 16 * 32, I_NI = 16 * 88, I_HI = 16 * 128, I_C1 = 32 * 2, I_C2 = 2;
    constexpr int NITEMS = 4 * I_FI + 4 * I_FO + 2 * I_PI + 2 * I_SQ + I_NI + I_SQ + I_HI + I_SQ + 2 * I_C1 + 2 * I_C2;
    for (int it0 = gw; it0 < NITEMS; it0 += NGW) {
        int it = it0; bool done = false;
        for (int m = 0; m < 4 && !done; ++m) done = conv_matrix<1>(it, P.ffn_in + (size_t)m * DM * 2 * DFF, 2 * DFF, DM, 2 * DFF, (h16*)(wb + W_FI + m * W_FI_SZ), scr, lane);
        for (int m = 0; m < 4 && !done; ++m) done = conv_matrix<0>(it, P.ffn_out + (size_t)m * DFF * DM, DM, DFF, DM, (h16*)(wb + W_FO + m * W_FO_SZ), scr, lane);
        for (int m = 0; m < 2 && !done; ++m) done = conv_matrix<0>(it, P.ple_in + (size_t)m * PLED * DM, DM, PLED, DM, (h16*)(wb + W_PI + m * W_PI_SZ), scr, lane);
        for (int m = 0; m < 2 && !done; ++m) done = conv_matrix<0>(it, P.ple_gate + (size_t)m * DM * DM, DM, DM, DM, (h16*)(wb + W_PG + m * W_SQ_SZ), scr, lane);
        if (!done) done = conv_matrix<2>(it, P.nsa_in, NSA_IN, DM, NSA_NP, (h16*)(wb + W_NI), scr, lane);
        if (!done) done = conv_matrix<0>(it, P.nsa_out, DM, DM, DM, (h16*)(wb + W_NO), scr, lane);
        if (!done) done = conv_matrix<0>(it, P.hg_in, 4096, DM, 4096, (h16*)(wb + W_HI), scr, lane);
        if (!done) done = conv_matrix<0>(it, P.hg_out, DM, DM, DM, (h16*)(wb + W_HO), scr, lane);
        for (int m = 0; m < 2 && !done; ++m) done = conv_matrix<0>(it, P.cmp_w1 + (size_t)m * 2048 * 64, 64, 2048, 64, (h16*)(wb + W_C1 + m * W_C1_SZ), scr, lane);
        for (int m = 0; m < 2 && !done; ++m) done = conv_matrix<0>(it, P.cmp_w2 + (size_t)m * 64 * 64, 64, 64, 64, (h16*)(wb + W_C2 + m * W_C2_SZ), scr, lane);
    }
    h16* Hb = (h16*)(P.ws + WS_H);
    for (int m = gw; m < T; m += NGW) rms_row_to_h16(P.x + (size_t)m * DM, P.ng, Hb + (size_t)m * DM, nullptr, lane);
    { const size_t n4 = (size_t)DEPTH * T * PLED / 4; const GAS f32x4* src = (const GAS f32x4*)P.p; GAS u32x2* dst = (GAS u32x2*)(P.ws + WS_PH);
      for (size_t i = (size_t)gw * 64 + lane; i < n4; i += (size_t)NGW * 64) { const f32x4 v = src[i]; u32x2 o; o.x = pkh(v.x, v.y); o.y = pkh(v.z, v.w); dst[i] = o; } }
    { float* rc = (float*)(P.ws + WS_ROPE_C); float* rs = (float*)(P.ws + WS_ROPE_S);
      for (int i = gw * 64 + lane; i < SEQ * 32; i += NGW * 64) { const int pos = i >> 5, k = i & 31;
          const float inv = (float)pow(10000.0, -(double)k / 32.0); const float ang = (float)pos * inv;
          rc[i] = (float)cos((double)ang); rs[i] = (float)sin((double)ang); } }
    { float* lb = (float*)(P.ws + WS_MISC + 4096);
      for (int i = gw * 64 + lane; i < 1024; i += NGW * 64) { const float l0 = P.hg_lb[i], l1 = P.hg_lb[1024 + i]; const float mx = fmaxf(l0, l1);
          const float e0 = expf(l0 - mx), e1 = expf(l1 - mx); lb[i] = e1 / (e0 + e1); } }
    if (gw < 128) { const int kv = gw >> 6, o = gw & 63; const float* pos = P.cmp_pos + kv * 2048; const float* w1 = P.cmp_w1 + (size_t)kv * 2048 * 64;
        float s = 0.f; for (int k = lane; k < 2048; k += 64) s += pos[k] * w1[(size_t)k * 64 + o];
        s = wave_sum(s); if (lane == 0) ((float*)(P.ws + WS_MISC))[gw] = s; }
}

DI void thin_phase(const float* xin, float* x, const h16* y, const float* gpost, float alpha, const float* gpre, h16* hout, int vcu, int G, int wave, int lane) {
    const int gw = vcu * NWAVES + wave, NGW = G * NWAVES;
    f32x4 gp[4], gq[4];
#pragma unroll
    for (int j = 0; j < 2; ++j) { gp[2 * j] = ((const GAS f32x4*)gpost)[2 * lane + 128 * j]; gp[2 * j + 1] = ((const GAS f32x4*)gpost)[2 * lane + 1 + 128 * j];
        if (gpre) { gq[2 * j] = ((const GAS f32x4*)gpre)[2 * lane + 128 * j]; gq[2 * j + 1] = ((const GAS f32x4*)gpre)[2 * lane + 1 + 128 * j]; } }
    for (int m = gw; m < T; m += NGW) {
        GAS f32x4* xr = (GAS f32x4*)(x + (size_t)m * DM); const GAS f32x4* xi = (const GAS f32x4*)(xin + (size_t)m * DM); const GAS h16x8* yr = (const GAS h16x8*)(y + (size_t)m * DM);
        f32x4 xv[4], yv[4]; float s = 0.f;
#pragma unroll
        for (int j = 0; j < 2; ++j) { const h16x8 t = yr[lane + 64 * j];
            yv[2 * j] = (f32x4){(float)t[0], (float)t[1], (float)t[2], (float)t[3]}; yv[2 * j + 1] = (f32x4){(float)t[4], (float)t[5], (float)t[6], (float)t[7]};
            xv[2 * j] = xi[2 * lane + 128 * j]; xv[2 * j + 1] = xi[2 * lane + 1 + 128 * j]; }
#pragma unroll
        for (int j = 0; j < 4; ++j) s += (yv[j].x * yv[j].x + yv[j].y * yv[j].y) + (yv[j].z * yv[j].z + yv[j].w * yv[j].w);
        const float r = rsqrtf(wave_sum(s) * (1.f / DM) + NORM_EPS) * alpha; float s2 = 0.f;
#pragma unroll
        for (int j = 0; j < 4; ++j) { xv[j] = xv[j] + yv[j] * r * gp[j]; s2 += (xv[j].x * xv[j].x + xv[j].y * xv[j].y) + (xv[j].z * xv[j].z + xv[j].w * xv[j].w); }
#pragma unroll
        for (int j = 0; j < 2; ++j) { xr[2 * lane + 128 * j] = xv[2 * j]; xr[2 * lane + 1 + 128 * j] = xv[2 * j + 1]; }
        if (gpre) { const float r2 = rsqrtf(wave_sum(s2) * (1.f / DM) + NORM_EPS);
#pragma unroll
            for (int j = 0; j < 2; ++j) *(GAS u32x4*)(hout + (size_t)m * DM + 8 * lane + 512 * j) = pkh8(xv[2 * j] * r2 * gq[2 * j], xv[2 * j + 1] * r2 * gq[2 * j + 1]); }
    }
}

struct EpiPlain {
    static constexpr bool PERM = true, AFTER_DRAIN = false;
    h16* O; int ldc;
    DI void operator()(const f32x4 (&acc)[2][2][4][2], const pg8::Unit& u, int wr, int wc, int fr_, int fq_) const {
        int fr = fr_, fq = fq_; asm volatile("" : "+v"(fr), "+v"(fq));
        const int row0 = u.pm * 256 + wr * 64 + fr, col0 = u.pn * 256 + wc * 32 + 8 * fq;
#pragma unroll
        for (int ai = 0; ai < 2; ++ai)
#pragma unroll
            for (int m = 0; m < 4; ++m) { h16* rowp = O + (size_t)(row0 + ai * 128 + m * 16) * ldc + col0;
#pragma unroll
                for (int bj = 0; bj < 2; ++bj) *(GAS u32x4*)(rowp + bj * 128) = pkh8(acc[ai][bj][m][0], acc[ai][bj][m][1]); }
    }
};
struct EpiSwiglu {
    static constexpr bool PERM = true, AFTER_DRAIN = false;
    h16* O;
    DI void operator()(const f32x4 (&acc)[2][2][4][2], const pg8::Unit& u, int wr, int wc, int fr_, int fq_) const {
        int fr = fr_, fq = fq_; asm volatile("" : "+v"(fr), "+v"(fq));
        const int row0 = u.pm * 256 + wr * 64 + fr, col0 = u.pn * 128 + wc * 32 + 8 * fq;
#pragma unroll
        for (int ai = 0; ai < 2; ++ai)
#pragma unroll
            for (int m = 0; m < 4; ++m) { f32x4 v[2];
#pragma unroll
                for (int n = 0; n < 2; ++n)
#pragma unroll
                    for (int i = 0; i < 4; ++i) v[n][i] = siluf_(acc[ai][0][m][n][i]) * acc[ai][1][m][n][i];
                *(GAS u32x4*)(O + (size_t)(row0 + ai * 128 + m * 16) * DFF + col0) = pkh8(v[0], v[1]); }
    }
};
struct EpiPleGate {
    static constexpr bool PERM = true, AFTER_DRAIN = false;
    const h16* PE; h16* O;
    DI void operator()(const f32x4 (&acc)[2][2][4][2], const pg8::Unit& u, int wr, int wc, int fr_, int fq_) const {
        int fr = fr_, fq = fq_; asm volatile("" : "+v"(fr), "+v"(fq));
        const int row0 = u.pm * 256 + wr * 64 + fr, col0 = u.pn * 256 + wc * 32 + 8 * fq;
#pragma unroll
        for (int ai = 0; ai < 2; ++ai)
#pragma unroll
            for (int m = 0; m < 4; ++m)
#pragma unroll
                for (int bj = 0; bj < 2; ++bj) { const size_t off = (size_t)(row0 + ai * 128 + m * 16) * DM + col0 + bj * 128;
                    asm volatile("" ::: "memory");
                    const h16x8 pe = *(const GAS h16x8*)(PE + off); f32x4 v[2];
#pragma unroll
                    for (int n = 0; n < 2; ++n)
#pragma unroll
                        for (int i = 0; i < 4; ++i) v[n][i] = (float)pe[4 * n + i] * sigmoidf_(acc[ai][bj][m][n][i]);
                    *(GAS u32x4*)(O + off) = pkh8(v[0], v[1]); }
    }
};
struct EpiNsaIn {
    static constexpr bool PERM = true, AFTER_DRAIN = false;
    unsigned char* xb; const float* rc; const float* rs; unsigned* kmax;
    DI void operator()(const f32x4 (&acc)[2][2][4][2], const pg8::Unit& u, int wr, int wc, int fr_, int fq_) const {
        int fr = fr_, fq = fq_; asm volatile("" : "+v"(fr), "+v"(fq));
        const int row0 = u.pm * 256 + wr * 64 + fr; const int pn = u.pn;
        if (pn == 10) {
            float* gt = (float*)(xb + X_GATES); const int j0 = wc * 32 + 8 * fq;
#pragma unroll
            for (int ai = 0; ai < 2; ++ai)
#pragma unroll
                for (int m = 0; m < 4; ++m) { const int row = row0 + ai * 128 + m * 16;
#pragma unroll
                    for (int n = 0; n < 2; ++n) { const int j = j0 + 4 * n; if (j < 48) { f32x4 g;
#pragma unroll
                        for (int i = 0; i < 4; ++i) g[i] = sigmoidf_(acc[ai][0][m][n][i]);
                        *(GAS f32x4*)(gt + (size_t)row * 48 + j) = g; } } }
            return;
        }
        const bool rope = (pn < 4) || pn == 4 || pn == 6 || pn == 8;
        const float sc = (pn < 4) ? 0.125f * LOG2E : 1.0f;
        h16* dst; int ld, colb;
        if (pn < 4) { dst = (h16*)(xb + X_Q); ld = 1024; colb = (4 * pn + wc) * 64; }
        else { dst = (h16*)(xb + X_KC + (size_t)(pn - 4) * 16 * MiB); ld = 64; colb = 0; }
        const int d0 = 8 * fq; float nrm = 0.f;
#pragma unroll
        for (int ai = 0; ai < 2; ++ai)
#pragma unroll
            for (int m = 0; m < 4; ++m) { const int row = row0 + ai * 128 + m * 16;
                asm volatile("" ::: "memory");
                f32x4 o1[2], o2[2];
                if (rope) { const int pos = row & (SEQ - 1);
#pragma unroll
                    for (int n = 0; n < 2; ++n) { const f32x4 c = *(const GAS f32x4*)(rc + pos * 32 + d0 + 4 * n), s = *(const GAS f32x4*)(rs + pos * 32 + d0 + 4 * n);
                        const f32x4 x1 = acc[ai][0][m][n], x2 = acc[ai][1][m][n];
                        o1[n] = (x1 * c - x2 * s) * sc; o2[n] = (x2 * c + x1 * s) * sc; } }
                else { o1[0] = acc[ai][0][m][0]; o1[1] = acc[ai][0][m][1]; o2[0] = acc[ai][1][m][0]; o2[1] = acc[ai][1][m][1]; }
                const size_t rrow = (pn < 4) ? (size_t)row : ((size_t)((row >> 14) * NG + wc) * SEQ + (row & (SEQ - 1)));
                h16* rp = dst + rrow * ld + colb + d0;
                const u32x4 w1 = pkh8(o1[0], o1[1]), w2 = pkh8(o2[0], o2[1]);
                *(GAS u32x4*)(rp) = w1; *(GAS u32x4*)(rp + 32) = w2;
                if (pn == 6 || pn == 8) {
                    const h16x8 a8 = __builtin_bit_cast(h16x8, w1), b8 = __builtin_bit_cast(h16x8, w2); float s = 0.f;
#pragma unroll
                    for (int i = 0; i < 8; ++i) s += (float)a8[i] * (float)a8[i] + (float)b8[i] * (float)b8[i];
                    s += __shfl_xor(s, 16); s += __shfl_xor(s, 32);
                    nrm = fmaxf(nrm, s); } }
        if (pn == 6 || pn == 8) {
#pragma unroll
            for (int o = 1; o < 16; o <<= 1) nrm = fmaxf(nrm, __shfl_xor(nrm, o));
            if ((fr | fq) == 0) atomicMax(kmax + ((row0 >> 14) * NG + wc) * 2 + (pn == 8 ? 1 : 0), __float_as_uint(nrm)); }
    }
};
struct EpiHgIn {
    static constexpr bool PERM = true, AFTER_DRAIN = false;
    unsigned char* xb; h16* GH; const float* lb;
    DI void operator()(const f32x4 (&acc)[2][2][4][2], const pg8::Unit& u, int wr, int wc, int fr_, int fq_) const {
        int fr = fr_, fq = fq_; asm volatile("" : "+v"(fr), "+v"(fq));
        const int row0 = u.pm * 256 + wr * 64 + fr; const int kind = u.pn >> 2; const int col0 = (u.pn & 3) * 256 + wc * 32 + 8 * fq;
        h16* dst = kind == 0 ? (h16*)(xb + X_QH) : kind == 1 ? (h16*)(xb + X_LF) : kind == 2 ? (h16*)(xb + X_VH) : GH;
        f32x4 lbv[2][2];
        if (kind == 1) {
#pragma unroll
            for (int bj = 0; bj < 2; ++bj)
#pragma unroll
                for (int n = 0; n < 2; ++n) lbv[bj][n] = *(const GAS f32x4*)(lb + col0 + bj * 128 + 4 * n); }
#pragma unroll
        for (int ai = 0; ai < 2; ++ai)
#pragma unroll
            for (int m = 0; m < 4; ++m)
#pragma unroll
                for (int bj = 0; bj < 2; ++bj) { f32x4 v[2];
                    asm volatile("" ::: "memory");
#pragma unroll
                    for (int n = 0; n < 2; ++n)
#pragma unroll
                        for (int i = 0; i < 4; ++i) { const float a = acc[ai][bj][m][n][i]; float r;
                            if (kind == 0 || kind == 3) r = siluf_(a);
                            else if (kind == 1) { const float l = lbv[bj][n][i]; r = __logf(l + (1.f - l) * sigmoidf_(a)); }
                            else r = a;
                            v[n][i] = r; }
                    *(GAS u32x4*)(dst + (size_t)(row0 + ai * 128 + m * 16) * DM + col0 + bj * 128) = pkh8(v[0], v[1]); }
    }
};

constexpr int CX_STR = 72;
DI void compress_phase(unsigned char* ws, LAS unsigned char* lds, int wgi, int G, int tid) {
    const int wave = __builtin_amdgcn_readfirstlane(tid >> 6), lane = tid & 63, fr = lane & 15, fq = lane >> 4;
    LAS h16* X = (LAS h16*)lds;
    LAS h16* MID = (LAS h16*)(lds + 528 * CX_STR * 2);
    const int mt = wave >> 2, nt = wave & 3;
    for (int u = wgi; u < 512; u += G) {
        const int kv = u >> 8, b = (u >> 7) & 1, g = (u >> 5) & 3, nb = u & 31, n0 = 32 * nb;
        const h16* src = (const h16*)(ws + WS_X + (kv ? X_VC : X_KC)) + (size_t)(b * NG + g) * SEQ * 64;
        for (int i = tid; i < 528 * 8; i += NTHREADS) { const int r = i >> 3, ch = i & 7; int tok = 16 * n0 + r; tok = tok < SEQ ? tok : SEQ - 1;
            *(LAS u32x4*)(X + r * CX_STR + ch * 8) = *(const GAS u32x4*)(src + (size_t)tok * 64 + ch * 8); }
        __syncthreads();
        const h16* w1t = (const h16*)(ws + WS_W + W_C1 + kv * W_C1_SZ) + (size_t)(16 * nt + fr) * 2048 + 8 * fq;
        f32x4 acc = {0.f, 0.f, 0.f, 0.f};
#pragma unroll 16
        for (int s = 0; s < 64; ++s) {
            const h16x8 a = *(const LAS h16x8*)(X + (16 * (16 * mt + fr) + (s >> 1)) * CX_STR + 32 * (s & 1) + 8 * fq);
            const h16x8 bw = *(const GAS h16x8*)(w1t + 32 * s);
            acc = __builtin_amdgcn_mfma_f32_16x16x32_f16(a, bw, acc, 0, 0, 0);
        }
        const float bias = ((const float*)(ws + WS_MISC))[kv * 64 + 16 * nt + fr];
#pragma unroll
        for (int i = 0; i < 4; ++i) MID[(16 * mt + 4 * fq + i) * CX_STR + 16 * nt + fr] = (h16)siluf_(acc[i] + bias);
        __syncthreads();
        const h16* w2t = (const h16*)(ws + WS_W + W_C2 + kv * W_C2_SZ) + (size_t)(16 * nt + fr) * 64 + 8 * fq;
        f32x4 acc2 = {0.f, 0.f, 0.f, 0.f};
#pragma unroll
        for (int s = 0; s < 2; ++s) {
            const h16x8 a = *(const LAS h16x8*)(MID + (16 * mt + fr) * CX_STR + 32 * s + 8 * fq);
            const h16x8 bw = *(const GAS h16x8*)(w2t + 32 * s);
            acc2 = __builtin_amdgcn_mfma_f32_16x16x32_f16(a, bw, acc2, 0, 0, 0);
        }
        h16* dst = (h16*)(ws + WS_X + (kv ? X_VCMP : X_KCMP)) + (size_t)(b * NG + g) * NCMP_P * 64;
#pragma unroll
        for (int i = 0; i < 4; ++i) { const int n = n0 + 16 * mt + 4 * fq + i; dst[(size_t)n * 64 + 16 * nt + fr] = (n < NCMP) ? (h16)acc2[i] : (h16)0.f; }
        __syncthreads();
    }
}

constexpr int AT_IMP = 49152, AT_SELM = LDSCTL_OFF + 1024, AT_END = AT_SELM + 2048;
static_assert(AT_IMP + 65536 <= RING_BYTES && AT_END <= LDS_BYTES, "attention LDS map");
constexpr float M_INIT = -1e30f, M_MASK = -3e30f;

DI int opaque(int x) { asm volatile("" : "+v"(x)); return x; }
#define WG_BAR() do { asm volatile("s_waitcnt lgkmcnt(0)" ::: "memory"); __builtin_amdgcn_s_barrier(); asm volatile("" ::: "memory"); } while (0)

DI int count_ge4(unsigned k0, unsigned k1, unsigned k2, unsigned k3, unsigned cand) {
    unsigned long long m0, m1, m2, m3;
    asm("v_cmp_le_u32_e64 %0, %4, %5\n\tv_cmp_le_u32_e64 %1, %4, %6\n\tv_cmp_le_u32_e64 %2, %4, %7\n\tv_cmp_le_u32_e64 %3, %4, %8"
        : "=&s"(m0), "=&s"(m1), "=&s"(m2), "=&s"(m3) : "s"(cand), "v"(k0), "v"(k1), "v"(k2), "v"(k3));
    return (__builtin_popcountll(m0) + __builtin_popcountll(m1)) + (__builtin_popcountll(m2) + __builtin_popcountll(m3));
}
DI float quad_sum(float v) {
    v += __builtin_bit_cast(float, __builtin_amdgcn_update_dpp(0, __builtin_bit_cast(int, v), 0xB1, 0xF, 0xF, true));
    v += __builtin_bit_cast(float, __builtin_amdgcn_update_dpp(0, __builtin_bit_cast(int, v), 0x4E, 0xF, 0xF, true));
    return v;
}
DI float col_max(float v) {
    const auto a = __builtin_amdgcn_permlane16_swap(__float_as_uint(v), __float_as_uint(v), false, false);
    const unsigned a0 = a[0], a1 = a[1];
    v = fmaxf(__uint_as_float(a0), __uint_as_float(a1));
    const auto b = __builtin_amdgcn_permlane32_swap(__float_as_uint(v), __float_as_uint(v), false, false);
    const unsigned b0 = b[0], b1 = b[1];
    return fmaxf(__uint_as_float(b0), __uint_as_float(b1));
}
DI float col_sum(float v) { v += __shfl_xor(v, 16); v += __shfl_xor(v, 32); return v; }

DI void glds16(const void* gsrc, unsigned lds_dst) { unsigned keep;
    asm volatile("s_mov_b32 %0, m0\n\ts_mov_b32 m0, %2\n\ts_nop 0\n\tglobal_load_lds_dwordx4 %1, off\n\ts_mov_b32 m0, %0" : "=&s"(keep) : "v"(gsrc), "s"(lds_dst) : "memory"); }
DI void sel_dma_tile(const h16* Kg, const h16* Vg, int ld, int t, LAS unsigned char* slot, int wave, int lane) {
    lane = opaque(lane);
    const int rl = lane >> 3, row = 8 * wave + rl, ch = (lane & 7) ^ rl;
    const unsigned goff = (unsigned)(((64 * t + row) * ld + ch * 8) * 2);
    const unsigned dst = (unsigned)(uintptr_t)(slot + wave * 1024);
    glds16((const char*)Kg + goff, dst);
    glds16((const char*)Vg + goff, dst + 8192u);
}
DI void at_kread(h16x8 (&kf)[8], const LAS h16* Kb, int fr, int fq) {
    const int r7 = fr & 7;
#pragma unroll
    for (int kb = 0; kb < 4; ++kb) { kf[2 * kb] = *(const LAS h16x8*)(Kb + (16 * kb + fr) * 64 + ((fq ^ r7) * 8)); kf[2 * kb + 1] = *(const LAS h16x8*)(Kb + (16 * kb + fr) * 64 + (((4 + fq) ^ r7) * 8)); }
    __builtin_amdgcn_sched_barrier(0);
}
DI void at_qk_mma(f32x4 (&st)[2][4], const h16x8 (&kf)[8], const h16x8 (&qf)[2][2], const float (&bias)[2], bool need0, bool need1) {
#pragma unroll
    for (int kb = 0; kb < 4; ++kb) {
        if (need0) { const f32x4 z = {bias[0], bias[0], bias[0], bias[0]}; st[0][kb] = __builtin_amdgcn_mfma_f32_16x16x32_f16(kf[2 * kb], qf[0][0], z, 0, 0, 0); st[0][kb] = __builtin_amdgcn_mfma_f32_16x16x32_f16(kf[2 * kb + 1], qf[0][1], st[0][kb], 0, 0, 0); }
        if (need1) { const f32x4 z = {bias[1], bias[1], bias[1], bias[1]}; st[1][kb] = __builtin_amdgcn_mfma_f32_16x16x32_f16(kf[2 * kb], qf[1][0], z, 0, 0, 0); st[1][kb] = __builtin_amdgcn_mfma_f32_16x16x32_f16(kf[2 * kb + 1], qf[1][1], st[1][kb], 0, 0, 0); }
    }
}
DI void at_vread(h16x8 (&vf)[8], const LAS h16* Vb, int fr, int fq) {
    const int q = fr >> 2, k7 = 4 * (fq & 1) + q, cl = (fr & 3) >> 1, in4 = 4 * (fr & 1);
#pragma unroll
    for (int s2 = 0; s2 < 2; ++s2)
#pragma unroll
        for (int db = 0; db < 4; ++db) {
            const LAS h16* p0 = Vb + (32 * s2 + 4 * fq + q) * 64 + (((2 * db + cl) ^ k7) * 8) + in4;
            const s16x4 r0 = __builtin_amdgcn_ds_read_tr16_b64_v4i16((LAS s16x4*)p0);
            const s16x4 r1 = __builtin_amdgcn_ds_read_tr16_b64_v4i16((LAS s16x4*)(p0 + 16 * 64));
            vf[4 * s2 + db] = __builtin_bit_cast(h16x8, __builtin_shufflevector(r0, r1, 0, 1, 2, 3, 4, 5, 6, 7)); }
    __builtin_amdgcn_sched_barrier(0);
}
DI void at_pv_mma(f32x4 (&o)[2][4], const h16x8 (&vf)[8], const h16x8 (&pb)[2][2], bool need0, bool need1) {
#pragma unroll
    for (int s2 = 0; s2 < 2; ++s2)
#pragma unroll
        for (int db = 0; db < 4; ++db) {
            if (need0) o[0][db] = __builtin_amdgcn_mfma_f32_16x16x32_f16(vf[4 * s2 + db], pb[0][s2], o[0][db], 0, 0, 0);
            if (need1) o[1][db] = __builtin_amdgcn_mfma_f32_16x16x32_f16(vf[4 * s2 + db], pb[1][s2], o[1][db], 0, 0, 0);
        }
}
DI h16x8 pack_p(const f32x4& a, const f32x4& b) { return __builtin_bit_cast(h16x8, pkh8(a, b)); }
DI void at_expsum(f32x4 (&st)[4], float& lrun, h16x8 (&pb)[2]) {
    float sum = 0.f;
#pragma unroll
    for (int kb = 0; kb < 4; ++kb)
#pragma unroll
        for (int i = 0; i < 4; ++i) { const float pp = __builtin_amdgcn_exp2f(st[kb][i]); st[kb][i] = pp; sum += pp; }
    lrun += sum;
    pb[0] = pack_p(st[0], st[1]); pb[1] = pack_p(st[2], st[3]);
}
#define DN_PIPE_BEGIN(Kg, Vg, ld, first, last)                                                                           \
    { sel_dma_tile(Kg, Vg, ld, (first), lds, wave, lane);                                                                \
      if ((first) + 1 <= (last)) sel_dma_tile(Kg, Vg, ld, (first) + 1, lds + 16384, wave, lane);                         \
      int sl_ = 0;                                                                                                       \
      for (int t_ = (first); t_ <= (last); ++t_) {                                                                       \
          if (t_ + 1 <= (last)) asm volatile("s_waitcnt vmcnt(2)" ::: "memory"); else asm volatile("s_waitcnt vmcnt(0)" ::: "memory");   \
          WG_BAR();                                                                                                      \
          { const int s2_ = sl_ >= 1 ? sl_ - 1 : 2; if (t_ + 2 <= (last)) sel_dma_tile(Kg, Vg, ld, t_ + 2, lds + s2_ * 16384, wave, lane); }   \
          const LAS h16* Kb = (const LAS h16*)(lds + sl_ * 16384); const LAS h16* Vb = Kb + 4096; (void)Vb;
#define DN_PIPE_END                                                                                                      \
          sl_ = sl_ == 2 ? 0 : sl_ + 1; }                                                                                \
      WG_BAR(); }

DI void attn_phase(unsigned char* ws, LAS unsigned char* lds, int wgi, int G, int tid) {
    const int wave = __builtin_amdgcn_readfirstlane(tid >> 6), lane = tid & 63, fr = lane & 15, fq = lane >> 4;
    const int tl = fr >> 2, hd = fr & 3;
    unsigned char* xb = ws + WS_X;
    LAS float* IMP = (LAS float*)(lds + AT_IMP) + wave * (8 * 256);
    LAS unsigned char* sb = (LAS unsigned char*)(lds + AT_SELM) + wave * 256;
    const float* gates = (const float*)(xb + X_GATES);
    for (int u = wgi; u < 2048; u += G) {
        const int bg = u & 7, b = bg >> 2, g = bg & 3, qq = u >> 3, ii = qq >> 5, rr = qq & 31;
        const int c = (ii & 1) ? (64 * (ii >> 1) + 63 - rr) : (64 * (ii >> 1) + rr);
        const size_t rowb = (size_t)b * SEQ;
        const int tw = 64 * c + 8 * wave;
        h16x8 qf[2][2];
#pragma unroll
        for (int a = 0; a < 2; ++a)
#pragma unroll
            for (int s = 0; s < 2; ++s)
                qf[a][s] = *(const GAS h16x8*)((const h16*)(xb + X_Q) + (rowb + tw + 4 * a + tl) * 1024 + (4 * g + hd) * 64 + 32 * s + 8 * fq);
        int tcol[2]; tcol[0] = tw + tl; tcol[1] = tw + 4 + tl;
        asm volatile("" :: "v"(qf[0][0]), "v"(qf[0][1]), "v"(qf[1][0]), "v"(qf[1][1]));
        GAS char* oscr = (GAS char*)(xb + X_OSCR + (size_t)wgi * 65536 + wave * 8192); const unsigned ooff = (unsigned)lane * 128u;
        const float zb[2] = {0.f, 0.f};
        float qn[2];
#pragma unroll
        for (int a = 0; a < 2; ++a) { float s = 0.f;
#pragma unroll
            for (int k2 = 0; k2 < 2; ++k2)
#pragma unroll
                for (int i = 0; i < 8; ++i) s += (float)qf[a][k2][i] * (float)qf[a][k2][i];
            qn[a] = sqrtf(col_sum(s)); }
        const float kmx_s = sqrtf(__uint_as_float(((const unsigned*)(ws + WS_CTL) + CW_KMAX)[(b * NG + g) * 2 + 0])) * 1.002f, kmx_w = sqrtf(__uint_as_float(((const unsigned*)(ws + WS_CTL) + CW_KMAX)[(b * NG + g) * 2 + 1])) * 1.002f;
        {
            const h16* Kg = (const h16*)(xb + X_KCMP) + (size_t)(b * NG + g) * NCMP_P * 64;
            const h16* Vg = (const h16*)(xb + X_VCMP) + (size_t)(b * NG + g) * NCMP_P * 64;
            const int ntc = (4 * c + 3 + 63) >> 6;
            const int tfull = (4 * c - 2 + 1) >> 6;
            int nmax[2];
#pragma unroll
            for (int a = 0; a < 2; ++a) nmax[a] = (tcol[a] >= 31) ? ((tcol[a] - 31) >> 4) : -1;
            f32x4 o[2][4];
#ifndef REP_CMP
#define REP_CMP 1
#endif
            _Pragma("unroll 1") for (int rep_ = 0; rep_ < REP_CMP; ++rep_) {
            float mrun[2] = {M_INIT, M_INIT}, lrun[2] = {0.f, 0.f};
            PROF_BEGIN(1);
            DN_PIPE_BEGIN(Kg, Vg, 64, 0, ntc - 1)
                h16x8 kf[8]; at_kread(kf, Kb, fr, fq); f32x4 st[2][4]; at_qk_mma(st, kf, qf, zb, true, true);
#pragma unroll
                for (int a = 0; a < 2; ++a) {
                    if (t_ >= tfull) {
#pragma unroll
                        for (int kb = 0; kb < 4; ++kb)
#pragma unroll
                            for (int i = 0; i < 4; ++i) { const int n = 64 * t_ + 16 * kb + 4 * fq + i; st[a][kb][i] = (n <= nmax[a]) ? st[a][kb][i] : M_MASK; }
                    }
                    float tmax = fmaxf(fmaxf(fmaxf(st[a][0][0], st[a][0][1]), fmaxf(st[a][0][2], st[a][0][3])), fmaxf(fmaxf(st[a][1][0], st[a][1][1]), fmaxf(st[a][1][2], st[a][1][3])));
                    tmax = fmaxf(tmax, fmaxf(fmaxf(fmaxf(st[a][2][0], st[a][2][1]), fmaxf(st[a][2][2], st[a][2][3])), fmaxf(fmaxf(st[a][3][0], st[a][3][1]), fmaxf(st[a][3][2], st[a][3][3]))));
                    const float mn = fmaxf(mrun[a], tmax); float sum = 0.f;
#pragma unroll
                    for (int kb = 0; kb < 4; ++kb)
#pragma unroll
                        for (int i = 0; i < 4; ++i) sum += __builtin_amdgcn_exp2f(st[a][kb][i] - mn);
                    lrun[a] = lrun[a] * __builtin_amdgcn_exp2f(mrun[a] - mn) + sum; mrun[a] = mn;
                }
            DN_PIPE_END
            PROF_END(1);
            float mcol[2], invl[2];
            PROF_BEGIN(2);
#pragma unroll
            for (int a = 0; a < 2; ++a) { const float mc = col_max(mrun[a]); const float lc = col_sum(lrun[a] * __builtin_amdgcn_exp2f(mrun[a] - mc)); mcol[a] = mc; invl[a] = 1.0f / fmaxf(lc, 1e-30f); }
#pragma unroll
            for (int a = 0; a < 2; ++a)
#pragma unroll
                for (int db = 0; db < 4; ++db) o[a][db] = (f32x4){0.f, 0.f, 0.f, 0.f};
            float carry[2] = {0.f, 0.f};
            const float nb2[2] = {-mcol[0], -mcol[1]};
            DN_PIPE_BEGIN(Kg, Vg, 64, 0, ntc - 1)
                h16x8 kf[8]; at_kread(kf, Kb, fr, fq); f32x4 st[2][4]; at_qk_mma(st, kf, qf, nb2, true, true);
                h16x8 vf[8]; at_vread(vf, Vb, fr, fq);
                h16x8 pb[2][2];
#pragma unroll
                for (int a = 0; a < 2; ++a) {
#pragma unroll
                    for (int kb = 0; kb < 4; ++kb)
#pragma unroll
                        for (int i = 0; i < 4; ++i) { const int n = 64 * t_ + 16 * kb + 4 * fq + i; const float e = __builtin_amdgcn_exp2f(st[a][kb][i]) * invl[a]; st[a][kb][i] = (t_ < tfull || n <= nmax[a]) ? e : 0.f; }
                    pb[a][0] = pack_p(st[a][0], st[a][1]); pb[a][1] = pack_p(st[a][2], st[a][3]);
                    if (c > 15) {
                        const int ln = opaque(lane), fq_ = ln >> 4, hd_ = ln & 3, tl_ = (ln & 15) >> 2;
                        float s4[4], p3[4], tt[4];
#pragma unroll
                        for (int kb = 0; kb < 4; ++kb) { s4[kb] = quad_sum((st[a][kb][0] + st[a][kb][1]) + (st[a][kb][2] + st[a][kb][3])); p3[kb] = quad_sum(st[a][kb][3]); }
#pragma unroll
                        for (int kb = 0; kb < 4; ++kb) tt[kb] = __shfl(p3[kb], (ln + 48) & 63);
#pragma unroll
                        for (int kb = 0; kb < 4; ++kb) { const float recv = (fq_ > 0) ? tt[kb] : (kb > 0 ? tt[kb > 0 ? kb - 1 : 0] : carry[a]);
                            const int j = 16 * t_ + 4 * kb + fq_;
                            if (hd_ == 0 && j < 256) IMP[(4 * a + tl_) * 256 + j] = s4[kb] + recv; }
                        carry[a] = tt[3];
                    }
                }
                at_pv_mma(o, vf, pb, true, true);
            DN_PIPE_END
            }
#pragma unroll
            for (int a = 0; a < 2; ++a) { const float gt = gates[(rowb + tcol[a]) * 48 + (4 * g + hd) * 3 + 0];
#pragma unroll
                for (int db = 0; db < 4; ++db) *(GAS f32x4*)(oscr + (a * 4 + db) * 16 + ooff) = o[a][db] * gt; }
        }
        PROF_END(2);
        PROF_BEGIN(3);
#ifndef REP_TOPK
#define REP_TOPK 1
#endif
        for (int rep_ = 0; rep_ < REP_TOPK; ++rep_) {
            const int lane = opaque(tid) & 63;
            unsigned bytes[4] = {0u, 0u, 0u, 0u};
            if (c <= 15) {
#pragma unroll
                for (int k = 0; k < 4; ++k) bytes[k] = (lane + 64 * k <= c) ? 0xFFu : 0u;
            } else {
#pragma unroll 1
                for (int tk0 = 0; tk0 < 8; tk0 += 4) {
                    unsigned key[4][4];
#pragma unroll
                    for (int q4 = 0; q4 < 4; ++q4)
#pragma unroll
                        for (int k = 0; k < 4; ++k) { const int j = lane + 64 * k; const unsigned ub = __builtin_bit_cast(unsigned, IMP[(tk0 + q4) * 256 + j]);
                            key[q4][k] = (j >= 1 && j <= c - 2) ? (((ub >> 7) << 8) | (unsigned)(255 - j)) : 0u; }
                    unsigned thr[4] = {0u, 0u, 0u, 0u};
#pragma unroll 1
                    for (int bit = 31; bit >= 0; --bit) {
#pragma unroll
                        for (int q4 = 0; q4 < 4; ++q4) { const unsigned cand = thr[q4] | (1u << bit);
                            if (count_ge4(key[q4][0], key[q4][1], key[q4][2], key[q4][3], cand) >= 13) thr[q4] = cand; } }
#pragma unroll
                    for (int q4 = 0; q4 < 4; ++q4)
#pragma unroll
                        for (int k = 0; k < 4; ++k) bytes[k] |= (key[q4][k] >= thr[q4] && key[q4][k] != 0u) ? (1u << (tk0 + q4)) : 0u;
                }
#pragma unroll
                for (int k = 0; k < 4; ++k) { const int j = lane + 64 * k; if (j == 0 || j == c || j == c - 1) bytes[k] = 0xFFu; }
            }
#pragma unroll
            for (int k = 0; k < 4; ++k) sb[lane + 64 * k] = (unsigned char)bytes[k];
        }
        WG_BAR();
        PROF_END(3); PROF_BEGIN(4);
        {
            const h16* Kg = (const h16*)(xb + X_KS) + (size_t)(b * NG + g) * SEQ * 64;
            const h16* Vg = (const h16*)(xb + X_VS) + (size_t)(b * NG + g) * SEQ * 64;
            float lrun[2];
            f32x4 o[2][4];
            const int nblk = c + 1, nbatch = (nblk + 3) >> 2;
#ifndef REP_SEL
#define REP_SEL 1
#endif
            for (int rep_ = 0; rep_ < REP_SEL; ++rep_) {
            lrun[0] = lrun[1] = 0.f;
#pragma unroll
            for (int a = 0; a < 2; ++a)
#pragma unroll
                for (int db = 0; db < 4; ++db) o[a][db] = (f32x4){0.f, 0.f, 0.f, 0.f};
#pragma unroll
            for (int bb = 0; bb < 4; ++bb) if (bb < nblk) sel_dma_tile(Kg, Vg, 64, bb, lds + bb * 16384, wave, lane);
            for (int e = 0; e < nbatch; ++e) {
                PROF_BEGIN(6); asm volatile("s_waitcnt vmcnt(0)" ::: "memory"); PROF_END(6); PROF_BEGIN(7); WG_BAR(); PROF_END(7);
                if (e + 1 < nbatch) {
#pragma unroll
                    for (int bb = 0; bb < 4; ++bb) { const int j = 4 * (e + 1) + bb; if (j < nblk) sel_dma_tile(Kg, Vg, 64, j, lds + (((e + 1) & 1) * 4 + bb) * 16384, wave, lane); } }
#pragma unroll 1
                for (int bb = 0; bb < 4; ++bb) {
                    const int j = 4 * e + bb; if (j >= nblk) break;
                    const unsigned tm = (unsigned)__builtin_amdgcn_readfirstlane((int)sb[j]);
                    const bool need0 = (tm & 0xFu) != 0u, need1 = (tm & 0xF0u) != 0u;
                    if (need0 || need1) {
                        const LAS h16* Kb = (const LAS h16*)(lds + ((e & 1) * 4 + bb) * 16384); const LAS h16* Vb = Kb + 4096;
                        float bias[2];
#pragma unroll
                        for (int a = 0; a < 2; ++a) bias[a] = ((tm >> (4 * a + tl)) & 1u) ? (14.f - qn[a] * kmx_s) : M_MASK;
                        h16x8 kf[8]; at_kread(kf, Kb, fr, fq); f32x4 st[2][4]; at_qk_mma(st, kf, qf, bias, need0, need1);
                        h16x8 vf[8]; at_vread(vf, Vb, fr, fq);
                        h16x8 pb[2][2];
#pragma unroll
                        for (int a = 0; a < 2; ++a) {
                            const bool need = a ? need1 : need0;
                            if (need) {
                                if (j == c) { const int tloc = tcol[a] - 64 * c;
#pragma unroll
                                    for (int kb = 0; kb < 4; ++kb)
#pragma unroll
                                        for (int i = 0; i < 4; ++i) st[a][kb][i] = (16 * kb + 4 * fq + i <= tloc) ? st[a][kb][i] : M_MASK; }
                                at_expsum(st[a], lrun[a], pb[a]);
                            } else { pb[a][0] = (h16x8){0, 0, 0, 0, 0, 0, 0, 0}; pb[a][1] = pb[a][0]; }
                        }
                        at_pv_mma(o, vf, pb, need0, need1);
                    }
                }
            }
            WG_BAR();
            }
#pragma unroll
            for (int a = 0; a < 2; ++a) { const float gt = gates[(rowb + tcol[a]) * 48 + (4 * g + hd) * 3 + 1] / fmaxf(col_sum(lrun[a]), 1e-30f);
#pragma unroll
                for (int db = 0; db < 4; ++db) o[a][db] = o[a][db] * gt; }
            { f32x4 prev[2][4];
#pragma unroll
              for (int a = 0; a < 2; ++a)
#pragma unroll
                for (int db = 0; db < 4; ++db) prev[a][db] = *(const GAS f32x4*)(oscr + (a * 4 + db) * 16 + ooff);
#pragma unroll
              for (int a = 0; a < 2; ++a)
#pragma unroll
                for (int db = 0; db < 4; ++db) *(GAS f32x4*)(oscr + (a * 4 + db) * 16 + ooff) = prev[a][db] + o[a][db]; }
        }
        PROF_END(4); PROF_BEGIN(5);
        {
            const h16* Kg = (const h16*)(xb + X_KW) + (size_t)(b * NG + g) * SEQ * 64;
            const h16* Vg = (const h16*)(xb + X_VW) + (size_t)(b * NG + g) * SEQ * 64;
            float lrun[2];
            f32x4 o[2][4];
            const int j0 = c >= 8 ? c - 8 : 0;
            const float wbias[2] = {14.f - qn[0] * kmx_w, 14.f - qn[1] * kmx_w};
#ifndef REP_WIN
#define REP_WIN 1
#endif
            for (int rep_ = 0; rep_ < REP_WIN; ++rep_) {
            lrun[0] = lrun[1] = 0.f;
#pragma unroll
            for (int a = 0; a < 2; ++a)
#pragma unroll
                for (int db = 0; db < 4; ++db) o[a][db] = (f32x4){0.f, 0.f, 0.f, 0.f};
            DN_PIPE_BEGIN(Kg, Vg, 64, j0, c)
                h16x8 kf[8]; at_kread(kf, Kb, fr, fq); f32x4 st[2][4]; at_qk_mma(st, kf, qf, wbias, true, true);
                h16x8 vf[8]; at_vread(vf, Vb, fr, fq);
                h16x8 pb[2][2];
#pragma unroll
                for (int a = 0; a < 2; ++a) {
                    if (t_ == c || t_ == c - 8) {
#pragma unroll
                        for (int kb = 0; kb < 4; ++kb)
#pragma unroll
                            for (int i = 0; i < 4; ++i) { const int kt = 64 * t_ + 16 * kb + 4 * fq + i; st[a][kb][i] = ((kt <= tcol[a]) && (kt > tcol[a] - 512)) ? st[a][kb][i] : M_MASK; }
                    }
                    at_expsum(st[a], lrun[a], pb[a]);
                }
                at_pv_mma(o, vf, pb, true, true);
            DN_PIPE_END
            }
#pragma unroll
            for (int a = 0; a < 2; ++a) { const float gt = gates[(rowb + tcol[a]) * 48 + (4 * g + hd) * 3 + 2] / fmaxf(col_sum(lrun[a]), 1e-30f);
#pragma unroll
                for (int db = 0; db < 4; ++db) o[a][db] = o[a][db] * gt; }
            { f32x4 prev[2][4];
#pragma unroll
              for (int a = 0; a < 2; ++a)
#pragma unroll
                for (int db = 0; db < 4; ++db) prev[a][db] = *(const GAS f32x4*)(oscr + (a * 4 + db) * 16 + ooff);
#pragma unroll
              for (int a = 0; a < 2; ++a)
#pragma unroll
                for (int db = 0; db < 4; ++db) { const f32x4 ot = prev[a][db] + o[a][db];
                    u32x2 w; w.x = pkh(ot[0], ot[1]); w.y = pkh(ot[2], ot[3]);
                    *(GAS u32x2*)((h16*)(ws + WS_H) + (rowb + tcol[a]) * 1024 + (4 * g + hd) * 64 + 16 * db + 4 * fq) = w; } }
        }
        PROF_END(5);
    }
}

constexpr int HQ_STR = 136;
constexpr int HK_STR = 24;
constexpr int HL_QT = 0, HL_KT = HL_QT + 16 * HQ_STR * 2, HL_KH = HL_KT + 16 * HQ_STR * 2, HL_VT = HL_KH + 128 * HK_STR * 2;
constexpr int HL_DEC = HL_VT + 128 * HK_STR * 2, HL_PART = HL_DEC + 512, HL_RED = HL_PART + 2048, HL_END = HL_RED + 512;
template <bool OUT> DI void hgrn_phase(unsigned char* ws, const float* hg_norm, LAS unsigned char* lds, int wgi, int G, int tid) {
    const int wave = __builtin_amdgcn_readfirstlane(tid >> 6), lane = tid & 63, fr = lane & 15, fq = lane >> 4;
    unsigned char* xb = ws + WS_X;
    LAS __bf16* QT = (LAS __bf16*)(lds + HL_QT); LAS __bf16* KT = (LAS __bf16*)(lds + HL_KT);
    LAS __bf16* KH = (LAS __bf16*)(lds + HL_KH); LAS __bf16* VT = (LAS __bf16*)(lds + HL_VT);
    LAS float* DEC = (LAS float*)(lds + HL_DEC); LAS float* PART = (LAS float*)(lds + HL_PART); LAS float* RED = (LAS float*)(lds + HL_RED);
    const int d = tid & 127, part = tid >> 7;
    float* ST = (float*)(xb + X_ST); float* DT = (float*)(xb + X_DT);
    for (int u = wgi; u < 256; u += G) {
        const int b = u >> 7, h = (u >> 4) & 7, sc = u & 15;
        const size_t row0 = (size_t)b * SEQ + (size_t)sc * 1024;
        const h16* qg = (const h16*)(xb + X_QH) + row0 * DM + h * 128 + d;
        const h16* fg = (const h16*)(xb + X_LF) + row0 * DM + h * 128 + d;
        const h16* vg = (const h16*)(xb + X_VH) + row0 * DM + h * 128 + d;
        f32x4 S[8];
#pragma unroll
        for (int db = 0; db < 8; ++db) S[db] = (f32x4){0.f, 0.f, 0.f, 0.f};
        if (OUT) {
            for (int i = 0; i < sc; ++i) { const float* st = ST + (size_t)(u - sc + i) * 16384; const float* dt = DT + (size_t)(u - sc + i) * 128;
#pragma unroll
                for (int db = 0; db < 8; ++db) { const f32x4 dv = *(const GAS f32x4*)(dt + 16 * db + 4 * fq);
#pragma unroll
                    for (int k = 0; k < 4; ++k) S[db][k] = S[db][k] * dv[k] + st[(size_t)(16 * db + 4 * fq + k) * 128 + 16 * wave + fr]; } }
        }
        float qv[4], lv[4], vv[4]; float dsum = 0.f;
#pragma unroll
        for (int k = 0; k < 4; ++k) { const size_t o = (size_t)(4 * part + k) * DM; qv[k] = (float)qg[o]; lv[k] = (float)fg[o]; vv[k] = (float)vg[o]; }
        for (int step = 0; step < 64; ++step) {
            float cum[4]; cum[0] = lv[0]; cum[1] = cum[0] + lv[1]; cum[2] = cum[1] + lv[2]; cum[3] = cum[2] + lv[3];
            PART[part * 128 + d] = cum[3];
            WG_BAR();
            float off = 0.f, tot = 0.f;
#pragma unroll
            for (int pp = 0; pp < 4; ++pp) { const float v = PART[pp * 128 + d]; tot += v; if (pp < part) off += v; }
            { b16x4 qt, kt, kh, vt;
#pragma unroll
              for (int k = 0; k < 4; ++k) { const float bt = off + cum[k]; const float kk = -expm1f(lv[k]);
                  const float eb = __expf(bt);
                  if (OUT) { QT[(4 * part + k) * HQ_STR + d] = (__bf16)(qv[k] * eb); KT[(4 * part + k) * HQ_STR + d] = (__bf16)(kk * __expf(fminf(-bt, 80.f))); }
                  kh[k] = (__bf16)(kk * __expf(tot - bt)); vt[k] = (__bf16)vv[k]; }
              *(LAS b16x4*)(KH + d * HK_STR + 4 * part) = kh; *(LAS b16x4*)(VT + d * HK_STR + 4 * part) = vt; }
            if (part == 0) { DEC[d] = __expf(tot); dsum += tot; }
            if (step + 1 < 64) {
#pragma unroll
                for (int k = 0; k < 4; ++k) { const size_t o = (size_t)(16 * (step + 1) + 4 * part + k) * DM; qv[k] = (float)qg[o]; lv[k] = (float)fg[o]; vv[k] = (float)vg[o]; } }
            WG_BAR();
            f32x4 ot = {0.f, 0.f, 0.f, 0.f};
            h16x4 gh = {0, 0, 0, 0}; f32x4 gn = {0.f, 0.f, 0.f, 0.f};
            if (OUT) { gh = *(const GAS h16x4*)((const h16*)(ws + WS_Y) + (row0 + 16 * step + fr) * DM + h * 128 + 16 * wave + 4 * fq); gn = *(const GAS f32x4*)(hg_norm + 16 * wave + 4 * fq); }
            if (OUT) {
                f32x4 at = {0.f, 0.f, 0.f, 0.f};
#pragma unroll
                for (int ks = 0; ks < 4; ++ks) { const b16x8 ka = *(const LAS b16x8*)(KT + fr * HQ_STR + 32 * ks + 8 * fq); const b16x8 qb = *(const LAS b16x8*)(QT + fr * HQ_STR + 32 * ks + 8 * fq);
                    at = __builtin_amdgcn_mfma_f32_16x16x32_bf16(ka, qb, at, 0, 0, 0); }
#pragma unroll
                for (int i = 0; i < 4; ++i) at[i] = (4 * fq + i <= fr) ? at[i] : 0.f;
                { const b16x4 v4 = *(const LAS b16x4*)(VT + (16 * wave + fr) * HK_STR + 4 * fq);
                  const b16x8 va = {v4[0], v4[1], v4[2], v4[3], (__bf16)0.f, (__bf16)0.f, (__bf16)0.f, (__bf16)0.f};
                  u32x4 pw; pw.x = pkb(at[0], at[1]); pw.y = pkb(at[2], at[3]); pw.z = 0u; pw.w = 0u;
                  ot = __builtin_amdgcn_mfma_f32_16x16x32_bf16(va, __builtin_bit_cast(b16x8, pw), ot, 0, 0, 0); }
#pragma unroll
                for (int ks = 0; ks < 4; ++ks) { u32x4 sw; sw.x = pkb(S[2 * ks][0], S[2 * ks][1]); sw.y = pkb(S[2 * ks][2], S[2 * ks][3]); sw.z = pkb(S[2 * ks + 1][0], S[2 * ks + 1][1]); sw.w = pkb(S[2 * ks + 1][2], S[2 * ks + 1][3]);
                    const b16x4 q0 = *(const LAS b16x4*)(QT + fr * HQ_STR + 32 * ks + 4 * fq), q1 = *(const LAS b16x4*)(QT + fr * HQ_STR + 32 * ks + 16 + 4 * fq);
                    const b16x8 qb = {q0[0], q0[1], q0[2], q0[3], q1[0], q1[1], q1[2], q1[3]};
                    ot = __builtin_amdgcn_mfma_f32_16x16x32_bf16(__builtin_bit_cast(b16x8, sw), qb, ot, 0, 0, 0); }
            }
            { b16x8 vb;
              if (fq < 2) vb = *(const LAS b16x8*)(VT + (16 * wave + fr) * HK_STR + 8 * fq); else vb = (b16x8){0, 0, 0, 0, 0, 0, 0, 0};
#pragma unroll
              for (int db = 0; db < 8; ++db) { const f32x4 dv = *(const LAS f32x4*)(DEC + 16 * db + 4 * fq);
                  b16x8 ka; if (fq < 2) ka = *(const LAS b16x8*)(KH + (16 * db + fr) * HK_STR + 8 * fq); else ka = (b16x8){0, 0, 0, 0, 0, 0, 0, 0};
                  S[db] = __builtin_amdgcn_mfma_f32_16x16x32_bf16(ka, vb, S[db] * dv, 0, 0, 0); } }
            if (OUT) {
                float ss = (ot[0] * ot[0] + ot[1] * ot[1]) + (ot[2] * ot[2] + ot[3] * ot[3]);
                ss = col_sum(ss);
                if (fq == 0) RED[wave * 16 + fr] = ss;
                WG_BAR();
                float tots = 0.f;
#pragma unroll
                for (int w2 = 0; w2 < 8; ++w2) tots += RED[w2 * 16 + fr];
                const float rstd = rsqrtf(tots * (1.f / 128.f) + NORM_EPS);
                const size_t orow = row0 + 16 * step + fr; const int ecol = 16 * wave + 4 * fq;
                u32x2 w; w.x = pkh(ot[0] * rstd * gn[0] * (float)gh[0], ot[1] * rstd * gn[1] * (float)gh[1]); w.y = pkh(ot[2] * rstd * gn[2] * (float)gh[2], ot[3] * rstd * gn[3] * (float)gh[3]);
                *(GAS u32x2*)((h16*)(ws + WS_H) + orow * DM + h * 128 + ecol) = w;
            }
        }
        if (!OUT) {
#pragma unroll
            for (int db = 0; db < 8; ++db)
#pragma unroll
                for (int k = 0; k < 4; ++k) ST[(size_t)u * 16384 + (size_t)(16 * db + 4 * fq + k) * 128 + 16 * wave + fr] = S[db][k];
            if (part == 0) DT[(size_t)u * 128 + d] = __expf(dsum);
        }
        __syncthreads();
    }
}

struct Args { Ptrs p; int ph_lo, ph_hi; };
constexpr int N_PHASES = 1 + 4 * 13;
#define NOINL __device__ __forceinline__
typedef const pg8::bf16_t* cbp;
NOINL void site_ffn_in(LAS unsigned char* lds, unsigned char* ws, int widx, int G, int bx, int tid) { asm volatile("" : "+s"(ws));
    pg8::Gemm g{(cbp)(ws + WS_H), (cbp)(ws + WS_W + W_FI + (size_t)widx * W_FI_SZ), T, 2 * DFF, DM, tid}; pg8::StaticOrder S; S.init(T, 2 * DFF, G, bx);
    EpiSwiglu E{(h16*)(ws + WS_X + X_ACT)}; pg8::gemm_phase<EpiSwiglu, pg8::StaticOrder, true, true>(lds, g, S, E); }
NOINL void site_ffn_out(LAS unsigned char* lds, unsigned char* ws, int widx, int G, int bx, int tid) { asm volatile("" : "+s"(ws));
    pg8::Gemm g{(cbp)(ws + WS_X + X_ACT), (cbp)(ws + WS_W + W_FO + (size_t)widx * W_FO_SZ), T, DM, DFF, tid}; pg8::StaticOrder S; S.init(T, DM, G, bx);
    EpiPlain E{(h16*)(ws + WS_Y), DM}; pg8::gemm_phase<EpiPlain, pg8::StaticOrder, true, true>(lds, g, S, E); }
NOINL void site_thin(const float* xin, float* x, unsigned char* ws, const float* gpost, float alpha, const float* gpre, int G, int bx, int tid) { asm volatile("" : "+s"(ws)); asm volatile("" : "+v"(tid));
    const int vcu = (G % 8 == 0) ? (bx % 8) * (G / 8) + bx / 8 : bx;
    thin_phase(xin, x, (const h16*)(ws + WS_Y), gpost, alpha, gpre, (h16*)(ws + WS_H), vcu, G, __builtin_amdgcn_readfirstlane(tid >> 6), tid & 63); }
NOINL void site_nsa_in(LAS unsigned char* lds, unsigned char* ws, int G, int bx, int tid) { asm volatile("" : "+s"(ws));
    pg8::Gemm g{(cbp)(ws + WS_H), (cbp)(ws + WS_W + W_NI), T, NSA_NP, DM, tid}; pg8::StaticOrder S; S.init(T, NSA_NP, G, bx);
    EpiNsaIn E{ws + WS_X, (const float*)(ws + WS_ROPE_C), (const float*)(ws + WS_ROPE_S), (unsigned*)(ws + WS_CTL) + CW_KMAX}; pg8::gemm_phase<EpiNsaIn, pg8::StaticOrder, true, true>(lds, g, S, E); }
NOINL void site_cmp(LAS unsigned char* lds, unsigned char* ws, int G, int bx, int tid) { asm volatile("" : "+s"(ws)); asm volatile("" : "+v"(tid)); compress_phase(ws, lds, bx, G, tid); }
NOINL void site_attn(LAS unsigned char* lds, unsigned char* ws, int G, int bx, int tid) { asm volatile("" : "+s"(ws)); asm volatile("" : "+v"(tid)); attn_phase(ws, lds, bx, G, tid); }
NOINL void site_hg_in(LAS unsigned char* lds, unsigned char* ws, int G, int bx, int tid) { asm volatile("" : "+s"(ws));
    pg8::Gemm g{(cbp)(ws + WS_H), (cbp)(ws + WS_W + W_HI), T, 4096, DM, tid}; pg8::StaticOrder S; S.init(T, 4096, G, bx);
    EpiHgIn E{ws + WS_X, (h16*)(ws + WS_Y), (const float*)(ws + WS_MISC + 4096)}; pg8::gemm_phase<EpiHgIn, pg8::StaticOrder, true, true>(lds, g, S, E); }
NOINL void site_hg_a(LAS unsigned char* lds, unsigned char* ws, int G, int bx, int tid) { asm volatile("" : "+s"(ws)); asm volatile("" : "+v"(tid)); hgrn_phase<false>(ws, nullptr, lds, bx, G, tid); }
NOINL void site_hg_b(LAS unsigned char* lds, unsigned char* ws, const float* hg_norm, int G, int bx, int tid) { asm volatile("" : "+s"(ws)); asm volatile("" : "+v"(tid)); hgrn_phase<true>(ws, hg_norm, lds, bx, G, tid); }
NOINL void site_mix_out(LAS unsigned char* lds, unsigned char* ws, size_t woff, int G, int bx, int tid) { asm volatile("" : "+s"(ws));
    pg8::Gemm g{(cbp)(ws + WS_H), (cbp)(ws + WS_W + woff), T, DM, DM, tid}; pg8::StaticOrder S; S.init(T, DM, G, bx);
    EpiPlain E{(h16*)(ws + WS_Y), DM}; pg8::gemm_phase<EpiPlain, pg8::StaticOrder, true, true>(lds, g, S, E); }
NOINL void site_ple_pe(LAS unsigned char* lds, unsigned char* ws, int l, int G, int bx, int tid) { asm volatile("" : "+s"(ws));
    int kk = PLED; asm volatile("" : "+s"(kk));
    pg8::Gemm g{(cbp)(ws + WS_PH + (size_t)l * T * PLED * 2), (cbp)(ws + WS_W + W_PI + (size_t)l * W_PI_SZ), T, DM, kk, tid}; pg8::StaticOrder S; S.init(T, DM, G, bx);
    EpiPlain E{(h16*)(ws + WS_X + X_PE), DM}; pg8::gemm_phase<EpiPlain, pg8::StaticOrder, true, true>(lds, g, S, E); }
NOINL void site_ple_gate(LAS unsigned char* lds, unsigned char* ws, int l, int G, int bx, int tid) { asm volatile("" : "+s"(ws));
    pg8::Gemm g{(cbp)(ws + WS_H), (cbp)(ws + WS_W + W_PG + (size_t)l * W_SQ_SZ), T, DM, DM, tid}; pg8::StaticOrder S; S.init(T, DM, G, bx);
    EpiPleGate E{(const h16*)(ws + WS_X + X_PE), (h16*)(ws + WS_Y)}; pg8::gemm_phase<EpiPleGate, pg8::StaticOrder, true, true>(lds, g, S, E); }

DI int lane_id_now() { int x; asm volatile("v_mbcnt_lo_u32_b32 %0, -1, 0\n\tv_mbcnt_hi_u32_b32 %0, -1, %0" : "=v"(x)); return x; }
__global__ void __launch_bounds__(NTHREADS, 2) fwd_kernel(Args args) {
    extern __shared__ __attribute__((aligned(16))) unsigned char lds_raw[];
    LAS unsigned char* lds = (LAS unsigned char*)lds_raw;
    const int wave_s = __builtin_amdgcn_readfirstlane((int)threadIdx.x >> 6);
#define tid ((wave_s << 6) | lane_id_now())
    const int G = gridDim.x, bx = blockIdx.x;
    if ((int)threadIdx.x < 32) ((LAS unsigned*)(lds + LDSCTL_OFF))[threadIdx.x] = 0u;
    __syncthreads();
    unsigned char* ws = args.p.ws;
    XcdBarrier bar = xcd_barrier_post((unsigned*)(ws + WS_CTL) + CW_BAR, (volatile LAS unsigned*)(lds + LDSCTL_OFF));
    const int lo = args.ph_lo, hi = args.ph_hi;
    int ph = 0;
#ifndef ENMASK
#define ENMASK 0xFFFF
#endif
#define EN(j) ((ENMASK >> (j)) & 1)
#define RUN(k) ((k) >= lo && (k) < hi)
#define SEAM(k) do { if (RUN(k) && RUN((k) + 1)) { PROF_BEGIN(200); xcd_barrier(bar); PROF_END(200); } } while (0)
    PROF_BEGIN(99);
    if (EN(0) && RUN(0)) { const int vcu = (G % 8 == 0) ? (bx % 8) * (G / 8) + bx / 8 : bx; p0_prologue(args.p, lds, vcu, G, __builtin_amdgcn_readfirstlane(tid >> 6), tid & 63); }
    PROF_END(99);
    SEAM(0);
#pragma unroll 1
    for (int hs = 0; hs < 2 * DEPTH; ++hs) {
        const int l = hs >> 1, second = hs & 1, base = 1 + hs * 13;
        const float* ng = args.p.ng + (size_t)l * 8 * DM;
        ph = base + 0; PROF_BEGIN(100); if (EN(1) && RUN(ph)) { site_ffn_in(lds, ws, 2 * l + second, G, bx, tid);
#ifdef DUP_FFNIN
 __syncthreads(); site_ffn_in(lds, ws, 2 * l + second, G, bx, tid);
#endif
 } PROF_END(ph - base + 100); SEAM(ph);
        ph = base + 1; PROF_BEGIN(101); if (EN(2) && RUN(ph)) site_ffn_out(lds, ws, 2 * l + second, G, bx, tid); PROF_END(ph - base + 100); SEAM(ph);
        ph = base + 2; PROF_BEGIN(102); if (EN(3) && RUN(ph)) site_thin(hs == 0 ? args.p.x : args.p.out, args.p.out, ws, ng + (second ? 5 : 1) * DM, 0.5f, ng + (second ? 6 : 2) * DM, G, bx, tid); PROF_END(ph - base + 100); SEAM(ph);
        if (!second) {
            if (l == 0) {
                ph = base + 3; PROF_BEGIN(103); if (EN(4) && RUN(ph)) site_nsa_in(lds, ws, G, bx, tid); PROF_END(ph - base + 100); SEAM(ph);
                ph = base + 4; PROF_BEGIN(104); if (EN(5) && RUN(ph)) { site_cmp(lds, ws, G, bx, tid);
#ifdef DUP_CMP
 __syncthreads(); site_cmp(lds, ws, G, bx, tid);
#endif
 } PROF_END(ph - base + 100); SEAM(ph);
                ph = base + 5; PROF_BEGIN(105); if (EN(6) && RUN(ph)) { site_attn(lds, ws, G, bx, tid);
#ifdef DUP_ATT
 __syncthreads(); site_attn(lds, ws, G, bx, tid);
#endif
 } PROF_END(ph - base + 100); SEAM(ph);
            } else {
                ph = base + 6; PROF_BEGIN(106); if (EN(7) && RUN(ph)) site_hg_in(lds, ws, G, bx, tid); PROF_END(ph - base + 100); SEAM(ph);
                ph = base + 7; PROF_BEGIN(107); if (EN(8) && RUN(ph)) { site_hg_a(lds, ws, G, bx, tid);
#ifdef DUP_HGA
 __syncthreads(); site_hg_a(lds, ws, G, bx, tid);
#endif
 } PROF_END(ph - base + 100); SEAM(ph);
                ph = base + 8; PROF_BEGIN(108); if (EN(9) && RUN(ph)) { site_hg_b(lds, ws, args.p.hg_norm, G, bx, tid);
#ifdef DUP_HGB
 __syncthreads(); site_hg_b(lds, ws, args.p.hg_norm, G, bx, tid);
#endif
 } PROF_END(ph - base + 100); SEAM(ph);
            }
            ph = base + 9; PROF_BEGIN(109); if (EN(10) && RUN(ph)) site_mix_out(lds, ws, l == 0 ? W_NO : W_HO, G, bx, tid); PROF_END(ph - base + 100); SEAM(ph);
            ph = base + 10; PROF_BEGIN(110); if (EN(11) && RUN(ph)) site_thin(args.p.out, args.p.out, ws, ng + 3 * DM, 1.0f, ng + 4 * DM, G, bx, tid); PROF_END(ph - base + 100); SEAM(ph);
        } else {
            ph = base + 11; PROF_BEGIN(111); if (EN(12) && RUN(ph)) {
#ifndef NO_PE
 site_ple_pe(lds, ws, l, G, bx, tid);
#endif
 asm volatile("s_waitcnt vmcnt(0)" ::: "memory"); __syncthreads();
#ifndef NO_GATE
 site_ple_gate(lds, ws, l, G, bx, tid);
#endif
 } PROF_END(ph - base + 100); SEAM(ph);
            ph = base + 12; PROF_BEGIN(112); if (EN(13) && RUN(ph)) site_thin(args.p.out, args.p.out, ws, ng + 7 * DM, 1.0f, (l + 1 < DEPTH) ? args.p.ng + (size_t)(l + 1) * 8 * DM : nullptr, G, bx, tid); PROF_END(ph - base + 100); SEAM(ph);
        }
    }
#ifdef PROF
    xcd_barrier(bar);
    if (threadIdx.x == 0) { const float tt = (float)*(LAS unsigned long long*)(lds + PROF_ACC);
#ifdef PROF_MIN
        args.p.out[bx] += 200000.0f / fmaxf(tt, 1.f);
#else
        args.p.out[bx] += tt * (1.0f / 20000.0f);
#endif
    }
#endif
#undef RUN
#undef SEAM
#undef tid
}

#ifndef MK_PER_PHASE
#define MK_PER_PHASE 0
#endif
extern "C" void kernel_launch(void* const* d_in, const int* in_sizes, int n_in, void* d_out, int out_size, void* d_ws, size_t ws_size, hipStream_t stream) {
    static int grid = 0;
    if (grid == 0) {
        if (n_in != 16 || in_sizes[0] != T * DM || out_size != T * DM || ws_size < WS_END) { fprintf(stderr, "kernel_launch: unexpected shapes / workspace (%d inputs, ws %zu)\n", n_in, ws_size); grid = -1; return; }
        int dev = 0, cus = 0, per_cu = 0;
        if (hipGetDevice(&dev) != hipSuccess || hipDeviceGetAttribute(&cus, hipDeviceAttributeMultiprocessorCount, dev) != hipSuccess) { grid = -1; return; }
        if (hipFuncSetAttribute((const void*)fwd_kernel, hipFuncAttributeMaxDynamicSharedMemorySize, LDS_BYTES) != hipSuccess) { grid = -1; return; }
        if (hipOccupancyMaxActiveBlocksPerMultiprocessor(&per_cu, (const void*)fwd_kernel, NTHREADS, LDS_BYTES) != hipSuccess || per_cu < 1) { fprintf(stderr, "kernel_launch: occupancy query says %d\n", per_cu); }
        (void)hipGetLastError();
        grid = cus;
    }
    if (grid < 0) return;
    if (hipMemsetAsync((char*)d_ws + WS_CTL, 0, CTL_ZERO_BYTES, stream) != hipSuccess) return;
    Args a{};
    const float* const* in = (const float* const*)d_in;
    a.p.x = in[0]; a.p.p = in[1]; a.p.ng = in[2]; a.p.ffn_in = in[3]; a.p.ffn_out = in[4]; a.p.ple_in = in[5]; a.p.ple_gate = in[6]; a.p.nsa_in = in[7]; a.p.nsa_out = in[8];
    a.p.cmp_pos = in[9]; a.p.cmp_w1 = in[10]; a.p.cmp_w2 = in[11]; a.p.hg_in = in[12]; a.p.hg_out = in[13]; a.p.hg_norm = in[14]; a.p.hg_lb = in[15];
    a.p.out = (float*)d_out; a.p.ws = (unsigned char*)d_ws;
#if MK_PER_PHASE
    for (int k = 0; k < N_PHASES; ++k) { a.ph_lo = k; a.ph_hi = k + 1; hipLaunchKernelGGL(fwd_kernel, dim3(grid), dim3(NTHREADS), LDS_BYTES, stream, a); }
#else
    a.ph_lo = 0; a.ph_hi = N_PHASES;
    hipLaunchKernelGGL(fwd_kernel, dim3(grid), dim3(NTHREADS), LDS_BYTES, stream, a);
#endif
}
```

```cpp
#include <hip/hip_runtime.h>
#include <cstdio>
#include <cstdint>
#include <cmath>
namespace pg8 {
#define PG8_LAS __attribute__((address_space(3)))
typedef unsigned short bf16_t;
typedef _Float16 bf16x8 __attribute__((ext_vector_type(8)));
typedef float f32x4 __attribute__((ext_vector_type(4)));
typedef unsigned u32x4 __attribute__((ext_vector_type(4)));
constexpr int BM = 256, BK = 64, HALF = 128, HTB = HALF * BK * 2  , STAGE_BYTES = 8 * HTB, NXCD = 8, WGM = 8;

__host__ __device__ __forceinline__ int lds_byte(int r, int c) { const int st = (r >> 4) * 2 + (c >> 5), rr = r & 15, cc = c & 31, ob = rr * 64 + cc * 2; return st * 1024 + (ob ^ (((ob >> 9) & 1) << 5)); }
__host__ __device__ __forceinline__ void stage_rc(int b, int& R, int& C) { const int st = b / 1024, sb = b % 1024, swz = sb ^ (((sb >> 9) & 1) << 5); R = (st >> 1) * 16 + swz / 64; C = (st & 1) * 32 + (swz % 64) / 2; }
__host__ __device__ __forceinline__ int perm32(int rho) { const int n = rho >> 4, i = rho & 15; return 8 * (i >> 2) + 4 * n + (i & 3); }

struct Unit { int pm, pn; };
struct Gemm { const bf16_t* A; const bf16_t* Bt; int M, N, K; int tid; };

struct StaticOrder {
    int nM, nN, nwg, G, c;
    __host__ __device__ void init(int M, int N, int G_, int c_) { nM = M / BM; nN = N / BM; nwg = nM * nN; G = G_; c = c_; }
    __host__ __device__ bool next(int i, Unit& u) const {
        const long L = (long)i * G + c; if (L >= nwg) return false;
        int wgid = (int)L; { const int q = nwg / NXCD, r = nwg % NXCD, xcd = wgid % NXCD, off = wgid / NXCD; wgid = (xcd < r ? xcd * (q + 1) : r * (q + 1) + (xcd - r) * q) + off; }
        const int nig = WGM * nN, gid = wgid / nig, fm = gid * WGM, gsz = (nM - fm) < WGM ? (nM - fm) : WGM;
        u.pm = fm + ((wgid % nig) % gsz); u.pn = (wgid % nig) / gsz; return true;
    }
    __device__ __forceinline__ void a_ready(const Unit&) const {}
    __device__ __forceinline__ void done(const Unit&) const {}
};

template <class Epi, class Sched, bool ALIGN_EPI = false, bool SP2 = false>
__device__ __forceinline__ void gemm_phase(PG8_LAS unsigned char* lds, const Gemm g, const Sched& S, const Epi& E) {
    int tid_l = g.tid; asm volatile("" : "+v"(tid_l));
    const int tid = tid_l, wid = __builtin_amdgcn_readfirstlane(tid >> 6), lane = tid & 63, wr = wid >> 2, wc = wid & 3, fr = lane & 15, fq = lane >> 4;
    const int K = g.K, nt = K / BK;
    unsigned voffA[2], voffB[2];
#pragma unroll
    for (int i = 0; i < 2; ++i) { int R, C; stage_rc(tid * 16 + i * 8192, R, C); const int Rb = Epi::PERM ? ((R & ~31) + perm32(R & 31)) : R;
        voffA[i] = (unsigned)(R * K + C) * 2u; voffB[i] = (unsigned)(Rb * K + C) * 2u; }
    const size_t kstep = (size_t)(BK * 2);
    const size_t hstep = (size_t)HALF * K * 2;
    const size_t tstep = 2 * hstep;
    const unsigned ldsw = (unsigned)wid * 1024u;
    const int aoff = lds_byte(wr * 64 + fr, fq * 8), boff = lds_byte(wc * 32 + fr, fq * 8);
#define PG8_SA(b, h) (((b) * 2 + (h)) * HTB)
#define PG8_SB(b, h) ((4 + (b) * 2 + (h)) * HTB)
#define PG8_STAGE(bufoff, gbase, voff) do { _Pragma("unroll") for (int _i = 0; _i < 2; ++_i) \
        __builtin_amdgcn_global_load_lds((const unsigned*)((const char*)(gbase) + (voff)[_i]), (PG8_LAS unsigned*)(lds + (bufoff) + ldsw + _i * 8192), 16, 0, 0); } while (0)
#define PG8_LDA(dst, b, h) do { _Pragma("unroll") for (int m = 0; m < 4; ++m) _Pragma("unroll") for (int k = 0; k < 2; ++k) dst[m][k] = *(const PG8_LAS bf16x8*)(lds + PG8_SA(b, h) + aoff + m * 2048 + k * 1024); } while (0)
#define PG8_LDB(dst, b, h) do { _Pragma("unroll") for (int n = 0; n < 2; ++n) _Pragma("unroll") for (int k = 0; k < 2; ++k) dst[n][k] = *(const PG8_LAS bf16x8*)(lds + PG8_SB(b, h) + boff + n * 2048 + k * 1024); } while (0)
#define PG8_MMA(ai, bj, At, Bt) do { __builtin_amdgcn_s_setprio(1); _Pragma("unroll") for (int m = 0; m < 4; ++m) _Pragma("unroll") for (int n = 0; n < 2; ++n) _Pragma("unroll") for (int k = 0; k < 2; ++k) \
        acc[ai][bj][m][n] = __builtin_amdgcn_mfma_f32_16x16x32_f16(Bt[n][k], At[m][k], acc[ai][bj][m][n], 0, 0, 0); __builtin_amdgcn_s_setprio(0); } while (0)
#define PG8_WAIT_V(n) asm volatile("s_waitcnt vmcnt(" #n ")" ::: "memory")
#define PG8_WAIT_L(n) asm volatile("s_waitcnt lgkmcnt(" #n ")" ::: "memory")
#define PG8_BAR __builtin_amdgcn_s_barrier()
#define PG8_SCHED __builtin_amdgcn_sched_barrier(0)
    Unit cur, nxt; int ui = 0;
    if (!S.next(0, cur)) return;
    f32x4 acc[2][2][4][2];
#pragma unroll
    for (int a = 0; a < 2; ++a)
#pragma unroll
        for (int b = 0; b < 2; ++b)
#pragma unroll
            for (int m = 0; m < 4; ++m)
#pragma unroll
                for (int n = 0; n < 2; ++n) acc[a][b][m][n] = (f32x4){0.f, 0.f, 0.f, 0.f};
    bf16x8 At[4][2], B0[2][2], B1[2][2];
    const char* cA = (const char*)g.A + (size_t)cur.pm * tstep; const char* cB = (const char*)g.Bt + (size_t)cur.pn * tstep;
    S.a_ready(cur);
    if constexpr (SP2) {
        PG8_STAGE(PG8_SB(0, 0), cB, voffB); PG8_STAGE(PG8_SB(0, 1), cB + hstep, voffB); PG8_STAGE(PG8_SA(0, 0), cA, voffA); PG8_STAGE(PG8_SA(0, 1), cA + hstep, voffA);
        if (wr == 1) PG8_BAR;
        PG8_WAIT_V(2); PG8_BAR;
        PG8_STAGE(PG8_SB(1, 0), cB + kstep, voffB); PG8_STAGE(PG8_SA(1, 0), cA + kstep, voffA); PG8_STAGE(PG8_SB(1, 1), cB + hstep + kstep, voffB);
        PG8_WAIT_V(6); PG8_BAR;
    } else {
        PG8_STAGE(PG8_SB(0, 0), cB, voffB); PG8_STAGE(PG8_SA(0, 0), cA, voffA); PG8_STAGE(PG8_SB(0, 1), cB + hstep, voffB); PG8_STAGE(PG8_SA(0, 1), cA + hstep, voffA);
        if (wr == 1) PG8_BAR;
        PG8_WAIT_V(4); PG8_BAR;
        PG8_STAGE(PG8_SB(1, 0), cB + kstep, voffB); PG8_STAGE(PG8_SA(1, 0), cA + kstep, voffA); PG8_STAGE(PG8_SB(1, 1), cB + hstep + kstep, voffB);
        PG8_WAIT_V(6); PG8_BAR;
    }
    for (;;) {
        const bool has_next = S.next(ui + 1, nxt);
        const char* nA = has_next ? (const char*)g.A + (size_t)nxt.pm * tstep : cA; const char* nB = has_next ? (const char*)g.Bt + (size_t)nxt.pn * tstep : cB;
        for (int t = 0; t < nt; t += 2) {
            const bool last = (t == nt - 2);
            const char* a1 = cA + (size_t)(t + 1) * kstep;
            const char* a2 = last ? nA : cA + (size_t)(t + 2) * kstep; const char* b2 = last ? nB : cB + (size_t)(t + 2) * kstep;
            const char* a3 = a2 + kstep; const char* b3 = b2 + kstep;
            if (last && has_next) S.a_ready(nxt);
            if constexpr (SP2) {
            PG8_LDB(B0, 0, 0); PG8_LDB(B1, 0, 1); PG8_SCHED; PG8_LDA(At, 0, 0); PG8_STAGE(PG8_SA(1, 1), a1 + hstep, voffA);
            PG8_WAIT_V(8); PG8_WAIT_L(0); PG8_BAR; PG8_MMA(0, 0, At, B0); PG8_MMA(0, 1, At, B1); PG8_BAR; PG8_SCHED;
            PG8_LDA(At, 0, 1); PG8_STAGE(PG8_SB(0, 0), b2, voffB); PG8_STAGE(PG8_SB(0, 1), b2 + hstep, voffB); PG8_STAGE(PG8_SA(0, 0), a2, voffA);
            PG8_WAIT_V(8); PG8_WAIT_L(0); PG8_BAR; PG8_MMA(1, 0, At, B0); PG8_MMA(1, 1, At, B1); PG8_BAR; PG8_SCHED;
            PG8_LDB(B0, 1, 0); PG8_LDB(B1, 1, 1); PG8_SCHED; PG8_LDA(At, 1, 0); PG8_STAGE(PG8_SA(0, 1), a2 + hstep, voffA);
            PG8_WAIT_V(8); PG8_WAIT_L(0); PG8_BAR; PG8_MMA(0, 0, At, B0); PG8_MMA(0, 1, At, B1); PG8_BAR; PG8_SCHED;
            PG8_LDA(At, 1, 1); PG8_STAGE(PG8_SB(1, 0), b3, voffB); PG8_STAGE(PG8_SB(1, 1), b3 + hstep, voffB); PG8_STAGE(PG8_SA(1, 0), a3, voffA);
            PG8_WAIT_V(8); PG8_WAIT_L(0); PG8_BAR; PG8_MMA(1, 0, At, B0); PG8_MMA(1, 1, At, B1); PG8_BAR; PG8_SCHED;
            } else {
            PG8_LDB(B0, 0, 0); PG8_SCHED; PG8_LDA(At, 0, 0); PG8_STAGE(PG8_SA(1, 1), a1 + hstep, voffA);
            PG8_WAIT_L(8); PG8_BAR; PG8_WAIT_L(0); PG8_MMA(0, 0, At, B0); PG8_BAR; PG8_SCHED;
            PG8_LDB(B1, 0, 1); PG8_STAGE(PG8_SB(0, 0), b2, voffB);
            PG8_BAR; PG8_WAIT_L(0); PG8_MMA(0, 1, At, B1); PG8_BAR;
            PG8_LDA(At, 0, 1); PG8_STAGE(PG8_SA(0, 0), a2, voffA);
            PG8_BAR; PG8_WAIT_L(0); PG8_MMA(1, 0, At, B0); PG8_BAR; PG8_SCHED;
            PG8_STAGE(PG8_SB(0, 1), b2 + hstep, voffB);
            PG8_WAIT_V(6); PG8_BAR; PG8_MMA(1, 1, At, B1); PG8_BAR;
            PG8_LDB(B0, 1, 0); PG8_SCHED; PG8_LDA(At, 1, 0); PG8_STAGE(PG8_SA(0, 1), a2 + hstep, voffA);
            PG8_WAIT_L(8); PG8_BAR; PG8_WAIT_L(0); PG8_MMA(0, 0, At, B0); PG8_BAR; PG8_SCHED;
            PG8_LDB(B1, 1, 1); PG8_STAGE(PG8_SB(1, 0), b3, voffB);
            PG8_BAR; PG8_WAIT_L(0); PG8_MMA(0, 1, At, B1); PG8_BAR;
            PG8_LDA(At, 1, 1); PG8_STAGE(PG8_SA(1, 0), a3, voffA);
            PG8_BAR; PG8_WAIT_L(0); PG8_MMA(1, 0, At, B0); PG8_BAR; PG8_SCHED;
            PG8_STAGE(PG8_SB(1, 1), b3 + hstep, voffB);
            PG8_WAIT_V(6); PG8_BAR; PG8_MMA(1, 1, At, B1); PG8_BAR;
            }
        }
        if constexpr (ALIGN_EPI) { if (wr == 0) PG8_BAR; }
        if constexpr (!Epi::AFTER_DRAIN) { E(acc, cur, wr, wc, fr, fq); S.done(cur); }
        if (!has_next) break;
#pragma unroll
        for (int a = 0; a < 2; ++a)
#pragma unroll
            for (int b = 0; b < 2; ++b)
#pragma unroll
                for (int m = 0; m < 4; ++m)
#pragma unroll
                    for (int n = 0; n < 2; ++n) acc[a][b][m][n] = (f32x4){0.f, 0.f, 0.f, 0.f};
        cur = nxt; cA = nA; cB = nB; ++ui;
        if constexpr (ALIGN_EPI) { if (wr == 1) PG8_BAR; }
    }
    PG8_WAIT_V(0);
    if constexpr (!ALIGN_EPI) { if (wr == 0) PG8_BAR; }
    PG8_BAR;
    if constexpr (Epi::AFTER_DRAIN) { E.fused(acc, cur, wr, wc, fr, fq, lds, wid, lane); S.done(cur); }
#undef PG8_SA
#undef PG8_SB
#undef PG8_STAGE
#undef PG8_LDA
#undef PG8_LDB
#undef PG8_MMA
#undef PG8_WAIT_V
#undef PG8_WAIT_L
#undef PG8_BAR
#undef PG8_SCHED
}
}

#define GAS __attribute__((address_space(1)))
#define LAS __attribute__((address_space(3)))
#define XB_TMO      128
#define XB_XCNT(j)  (256  + 64 * (j))
#define XB_XSUB(j)  (1280 + 64 * (j))
#define XB_XGEN(j)  (2304 + 64 * (j))
#define XB_TOP      3328
#define XB_TOPGEN   3392
#define XCD_BAR_WORDS 3456
#define XB_SPIN_CAP (1u << 18)

__device__ __forceinline__ unsigned xb_ld(unsigned* p)              { return __hip_atomic_load(p, __ATOMIC_RELAXED, __HIP_MEMORY_SCOPE_AGENT); }
__device__ __forceinline__ unsigned xb_add(unsigned* p, unsigned v) { return __hip_atomic_fetch_add(p, v, __ATOMIC_RELAXED, __HIP_MEMORY_SCOPE_AGENT); }
__device__ __forceinline__ unsigned xb_xcc_id() { return (unsigned)__builtin_amdgcn_s_getreg((3 << 11) | 20) & 0xFu; }
#define XB_SPIN(cond, bar) do { unsigned _sp = 0; while (cond) { __builtin_amdgcn_s_sleep(1); \
    if ((++_sp & 255u) == 0u) { if (xb_ld(&(bar)[XB_TMO])) break; if (_sp > XB_SPIN_CAP) { atomicAdd(&(bar)[XB_TMO], 1u); break; } } } } while (0)

struct XcdBarrier {
    unsigned* bar; unsigned x;
    volatile LAS unsigned* st;
};

__device__ __forceinline__ XcdBarrier xcd_barrier_post(unsigned* bar, volatile LAS unsigned* st) {
    XcdBarrier b; b.bar = bar; b.x = xb_xcc_id(); b.st = st;
    if (threadIdx.x == 0) (void)xb_add(&bar[XB_XCNT(b.x)], 1u);
    return b;
}
__device__ __forceinline__ void xcd_barrier_complete(unsigned* bar, unsigned x, unsigned& nloc, unsigned& nx) {
    const unsigned G = gridDim.x * gridDim.y * gridDim.z;
    unsigned sum, cnt, mine, sp = 0u;
    for (;;) {
        sum = 0u; cnt = 0u; mine = 0u;
#pragma unroll
        for (unsigned j = 0; j < 16; ++j) { const unsigned c = xb_ld(&bar[XB_XCNT(j)]); sum += c; cnt += (c > 0u) ? 1u : 0u; mine = (j == x) ? c : mine; }
        if (sum == G) break;
        __builtin_amdgcn_s_sleep(1);
        if ((++sp & 255u) == 0u) { if (xb_ld(&bar[XB_TMO])) break; if (sp > XB_SPIN_CAP) { atomicAdd(&bar[XB_TMO], 1u); break; } }
    }
    nloc = mine > 0u ? mine : 1u; nx = cnt > 0u ? cnt : 1u;
}

__device__ __forceinline__ void xcd_barrier(const XcdBarrier& b) {
    asm volatile("s_waitcnt vmcnt(0)" ::: "memory");
    __syncthreads();
    if (threadIdx.x == 0) {
        unsigned* bar = b.bar;
        __builtin_amdgcn_s_waitcnt(0);
        unsigned nloc = b.st[0], nx = b.st[1];
        if (nloc == 0u) { xcd_barrier_complete(bar, b.x, nloc, nx); b.st[0] = nloc; b.st[1] = nx; }
        const unsigned old = xb_add(&bar[XB_XSUB(b.x)], 1u);
        const unsigned gen = old / nloc;
        if (old + 1u == (gen + 1u) * nloc) {
            __builtin_amdgcn_fence(__ATOMIC_RELEASE, "agent");
            asm volatile("s_waitcnt vmcnt(0)" ::: "memory");
            const unsigned og = xb_add(&bar[XB_TOP], 1u);
            const unsigned tg = og / nx;
            if (og + 1u == (tg + 1u) * nx) xb_add(&bar[XB_TOPGEN], 1u);
            else XB_SPIN(xb_ld(&bar[XB_TOPGEN]) == tg, bar);
            __builtin_amdgcn_fence(__ATOMIC_ACQUIRE, "agent");
            xb_add(&bar[XB_XGEN(b.x)], 1u);
            asm volatile("s_waitcnt vmcnt(0)" ::: "memory");
        } else {
            XB_SPIN(xb_ld(&bar[XB_XGEN(b.x)]) == gen, bar);
            __builtin_amdgcn_fence(__ATOMIC_ACQUIRE, "agent");
            asm volatile("s_waitcnt vmcnt(0)" ::: "memory");
        }
    }
    __syncthreads();
}


constexpr int BATCH = 2, SEQ = 16384, DM = 1024, T = BATCH * SEQ, DFF = 2816, PLED = 256, DEPTH = 2;
constexpr int NH = 16, NG = 4, HD = 64, NSA_IN = 2608, NSA_NP = 2816;
constexpr int NCMP = 1023, NCMP_P = 1024;
constexpr int HG_H = 8, HG_D = 128;
constexpr float NORM_EPS = 1e-6f;
constexpr float LOG2E = 1.4426950408889634f;
constexpr int NWAVES = 8, NTHREADS = 512;

constexpr size_t MiB = 1u << 20;
constexpr size_t WS_CTL = 0, CTL_ZERO_BYTES = 512 * 1024;
constexpr size_t WS_ROPE_C = 1 * MiB, WS_ROPE_S = 3 * MiB;
constexpr size_t WS_MISC = 512 * 1024;
constexpr size_t WS_DT = 640 * 1024;
constexpr size_t WS_W = 5 * MiB;
constexpr size_t W_FI = 0;
constexpr size_t W_FI_SZ = (size_t)2 * DFF * DM * 2;
constexpr size_t W_FO = W_FI + 4 * W_FI_SZ;
constexpr size_t W_FO_SZ = (size_t)DM * DFF * 2;
constexpr size_t W_PI = W_FO + 4 * W_FO_SZ;
constexpr size_t W_PI_SZ = (size_t)DM * PLED * 2;
constexpr size_t W_PG = W_PI + 2 * W_PI_SZ;
constexpr size_t W_SQ_SZ = (size_t)DM * DM * 2;
constexpr size_t W_NI = W_PG + 2 * W_SQ_SZ;
constexpr size_t W_NI_SZ = (size_t)NSA_NP * DM * 2;
constexpr size_t W_NO = W_NI + W_NI_SZ;
constexpr size_t W_HI = W_NO + W_SQ_SZ;
constexpr size_t W_HI_SZ = (size_t)4096 * DM * 2;
constexpr size_t W_HO = W_HI + W_HI_SZ;
constexpr size_t W_C1 = W_HO + W_SQ_SZ;
constexpr size_t W_C1_SZ = (size_t)64 * 2048 * 2;
constexpr size_t W_C2 = W_C1 + 2 * W_C1_SZ;
constexpr size_t W_C2_SZ = (size_t)64 * 64 * 2;
constexpr size_t W_END = W_C2 + 2 * W_C2_SZ;
static_assert(W_END <= 90 * MiB, "weights region");
constexpr size_t WS_PH = 95 * MiB;
constexpr size_t WS_H = 111 * MiB;
constexpr size_t WS_Y = 175 * MiB;
constexpr size_t WS_X = 239 * MiB;
constexpr size_t WS_X16 = 447 * MiB;
constexpr size_t X_ACT = 0;
constexpr size_t X_Q = 0, X_KC = 64 * MiB, X_VC = 80 * MiB, X_KS = 96 * MiB, X_VS = 112 * MiB, X_KW = 128 * MiB, X_VW = 144 * MiB;
constexpr size_t X_GATES = 160 * MiB, X_KCMP = 168 * MiB, X_VCMP = 169 * MiB, X_OSCR = 170 * MiB;
constexpr size_t X_QH = 0, X_LF = 64 * MiB, X_VH = 128 * MiB, X_ST = 192 * MiB;
constexpr size_t X_PE = 0;
constexpr size_t WS_END = 511 * MiB;
constexpr int CW_BAR = 4096, CW_SS = 32768, CW_KMAX = 2048;

constexpr int RING_BYTES = 131072;
constexpr int LDSCTL_OFF = RING_BYTES;
constexpr int LDS_BYTES = 147456;

#ifdef PROF
#define PROF_T0 (LDSCTL_OFF + 64)
#define PROF_ACC (LDSCTL_OFF + 72)
#define PROF_BEGIN(id) do { if ((id) == PROF && threadIdx.x == 0) *(LAS unsigned long long*)(lds + PROF_T0) = __builtin_amdgcn_s_memrealtime(); } while (0)
#define PROF_END(id) do { if ((id) == PROF && threadIdx.x == 0) { *(LAS unsigned long long*)(lds + PROF_ACC) += __builtin_amdgcn_s_memrealtime() - *(LAS unsigned long long*)(lds + PROF_T0); } } while (0)
#else
#define PROF_BEGIN(id) do { } while (0)
#define PROF_END(id) do { } while (0)
#endif

typedef _Float16 h16;
typedef _Float16 h16x8 __attribute__((ext_vector_type(8)));
typedef _Float16 h16x4 __attribute__((ext_vector_type(4)));
typedef _Float16 h16x2 __attribute__((ext_vector_type(2)));
typedef __bf16 b16x8 __attribute__((ext_vector_type(8)));
typedef __bf16 b16x4 __attribute__((ext_vector_type(4)));
typedef float f32x4 __attribute__((ext_vector_type(4)));
typedef float f32x2 __attribute__((ext_vector_type(2)));
typedef unsigned u32x4 __attribute__((ext_vector_type(4)));
typedef unsigned u32x2 __attribute__((ext_vector_type(2)));
typedef short s16x4 __attribute__((ext_vector_type(4)));
typedef short s16x8 __attribute__((ext_vector_type(8)));

#define DI __device__ __forceinline__
#define LDS_WAIT() asm volatile("s_waitcnt lgkmcnt(0)" ::: "memory")

DI float wave_sum(float v) {
#pragma unroll
    for (int o = 1; o < 64; o <<= 1) v += __shfl_xor(v, o);
    return v;
}
DI float sigmoidf_(float x) { return __builtin_amdgcn_rcpf(1.0f + __expf(-x)); }
DI float siluf_(float x) { return x * __builtin_amdgcn_rcpf(1.0f + __expf(-x)); }
DI unsigned pkh(float a, float b) { h16x2 v = {(h16)a, (h16)b}; return __builtin_bit_cast(unsigned, v); }
DI u32x4 pkh8(f32x4 a, f32x4 b) { u32x4 w; w.x = pkh(a[0], a[1]); w.y = pkh(a[2], a[3]); w.z = pkh(b[0], b[1]); w.w = pkh(b[2], b[3]); return w; }
#ifdef ST_SC1
template <class P> DI void st16(P p, u32x4 v) { asm volatile("global_store_dwordx4 %0, %1, off sc1\n\ts_nop 1" :: "v"((unsigned long long)p), "v"(v) : "memory"); }
#else
template <class P> DI void st16(P p, u32x4 v) { *(GAS u32x4*)(unsigned long long)p = v; }
#endif
DI unsigned pkb(float a, float b) { typedef __bf16 b2 __attribute__((ext_vector_type(2))); f32x2 f = {a, b}; b2 v = __builtin_convertvector(f, b2); return __builtin_bit_cast(unsigned, v); }

struct Ptrs {
    const float *x, *p, *ng, *ffn_in, *ffn_out, *ple_in, *ple_gate, *nsa_in, *nsa_out, *cmp_pos, *cmp_w1, *cmp_w2, *hg_in, *hg_out, *hg_norm, *hg_lb;
    float* out; unsigned char* ws;
};

DI void transpose_item(const float* W, int ldw, int K, h16* WT, int dstrow0, int srccol0, int nvalid, int k0, LAS float* scr, int lane) {
    const int nn = lane & 31;
    float wv[32];
#pragma unroll
    for (int i = 0; i < 32; ++i) { const int kk = 2 * i + (lane >> 5); wv[i] = (nn < nvalid) ? W[(size_t)(k0 + kk) * ldw + srccol0 + nn] : 0.f; }
#pragma unroll
    for (int i = 0; i < 32; ++i) { const int kk = 2 * i + (lane >> 5); scr[kk * 33 + nn] = wv[i]; }
    LDS_WAIT(); asm volatile("" ::: "memory");
    const int c = lane & 7;
#pragma unroll
    for (int j = 0; j < 4; ++j) { const int n = (lane >> 3) + 8 * j; const LAS float* s = scr + (8 * c) * 33 + n;
        u32x4 o; o.x = pkh(s[0 * 33], s[1 * 33]); o.y = pkh(s[2 * 33], s[3 * 33]); o.z = pkh(s[4 * 33], s[5 * 33]); o.w = pkh(s[6 * 33], s[7 * 33]);
        *(GAS u32x4*)(WT + (size_t)(dstrow0 + n) * K + k0 + 8 * c) = o; }
    LDS_WAIT(); asm volatile("" ::: "memory");
}
template <int MAP> DI bool conv_matrix(int& it, const float* W, int ldw, int K, int NR, h16* WT, LAS float* scr, int lane) {
    const int nrb = NR / 32, nitems = (K / 64) * nrb;
    if (it >= nitems) { it -= nitems; return false; }
    const int kb = it / nrb, rb = it % nrb, c0 = 32 * rb;
    int src = c0, nvalid = 32;
    if (MAP == 1) { const int pn = c0 >> 8, bj = (c0 >> 7) & 1, j0 = c0 & 127; src = bj * DFF + 128 * pn + j0; }
    if (MAP == 2) { const int pn = c0 >> 8, bj = (c0 >> 7) & 1, hl = (c0 & 127) >> 5;
        if (pn < 4) src = (4 * pn + hl) * 64 + 32 * bj;
        else if (pn < 10) src = 1024 + (pn - 4) * 256 + hl * 64 + 32 * bj;
        else { const int jj = c0 & 255; src = 2560 + jj; nvalid = 48 - jj; nvalid = nvalid < 0 ? 0 : (nvalid > 32 ? 32 : nvalid); if (nvalid == 0) src = 0; } }
    transpose_item(W, ldw, K, WT, c0, src, nvalid, 64 * kb, scr, lane);
    return true;
}
DI void rms_row_to_h16(const float* xrow, const float* gain, h16* orow, float* xcopy, int lane) {
    const GAS f32x4* xr = (const GAS f32x4*)xrow; const GAS f32x4* gr = (const GAS f32x4*)gain;
    f32x4 v[4]; float s = 0.f;
#pragma unroll
    for (int j = 0; j < 2; ++j) { v[2 * j] = xr[2 * lane + 128 * j]; v[2 * j + 1] = xr[2 * lane + 1 + 128 * j]; }
#pragma unroll
    for (int j = 0; j < 4; ++j) s += (v[j].x * v[j].x + v[j].y * v[j].y) + (v[j].z * v[j].z + v[j].w * v[j].w);
    const float r = rsqrtf(wave_sum(s) * (1.f / DM) + NORM_EPS);
#pragma unroll
    for (int j = 0; j < 2; ++j) {
        if (xcopy) { ((GAS f32x4*)xcopy)[2 * lane + 128 * j] = v[2 * j]; ((GAS f32x4*)xcopy)[2 * lane + 1 + 128 * j] = v[2 * j + 1]; }
        const f32x4 g0 = gr[2 * lane + 128 * j], g1 = gr[2 * lane + 1 + 128 * j];
        *(GAS u32x4*)(orow + 8 * lane + 512 * j) = pkh8(v[2 * j] * r * g0, v[2 * j + 1] * r * g1); }
}
DI void p0_prologue(const Ptrs& P, LAS unsigned char* lds, int vcu, int G, int wave, int lane) {
    LAS float* scr = (LAS float*)(lds + wave * 16384);
    const int gw = vcu * NWAVES + wave, NGW = G * NWAVES;
    unsigned char* wb = P.ws + WS_W;
    constexpr int I_FI = 16 * 176, I_FO = 44 * 32, I_PI = 4 * 32, I_SQ = 16 * 32, I_NI = 16 * 88, I_HI = 16 * 128, I_C1 = 32 * 2, I_C2 = 2;
    constexpr int NITEMS = 4 * I_FI + 4 * I_FO + 2 * I_PI + 2 * I_SQ + I_NI + I_SQ + I_HI + I_SQ + 2 * I_C1 + 2 * I_C2;
    for (int it0 = gw; it0 < NITEMS; it0 += NGW) {
        int it = it0; bool done = false;
        for (int m = 0; m < 4 && !done; ++m) done = conv_matrix<1>(it, P.ffn_in + (size_t)m * DM * 2 * DFF, 2 * DFF, DM, 2 * DFF, (h16*)(wb + W_FI + m * W_FI_SZ), scr, lane);
        for (int m = 0; m < 4 && !done; ++m) done = conv_matrix<0>(it, P.ffn_out + (size_t)m * DFF * DM, DM, DFF, DM, (h16*)(wb + W_FO + m * W_FO_SZ), scr, lane);
        for (int m = 0; m < 2 && !done; ++m) done = conv_matrix<0>(it, P.ple_in + (size_t)m * PLED * DM, DM, PLED, DM, (h16*)(wb + W_PI + m * W_PI_SZ), scr, lane);
        for (int m = 0; m < 2 && !done; ++m) done = conv_matrix<0>(it, P.ple_gate + (size_t)m * DM * DM, DM, DM, DM, (h16*)(wb + W_PG + m * W_SQ_SZ), scr, lane);
        if (!done) done = conv_matrix<2>(it, P.nsa_in, NSA_IN, DM, NSA_NP, (h16*)(wb + W_NI), scr, lane);
        if (!done) done = conv_matrix<0>(it, P.nsa_out, DM, DM, DM, (h16*)(wb + W_NO), scr, lane);
        if (!done) done = conv_matrix<0>(it, P.hg_in, 4096, DM, 4096, (h16*)(wb + W_HI), scr, lane);
        if (!done) done = conv_matrix<0>(it, P.hg_out, DM, DM, DM, (h16*)(wb + W_HO), scr, lane);
        for (int m = 0; m < 2 && !done; ++m) done = conv_matrix<0>(it, P.cmp_w1 + (size_t)m * 2048 * 64, 64, 2048, 64, (h16*)(wb + W_C1 + m * W_C1_SZ), scr, lane);
        for (int m = 0; m < 2 && !done; ++m) done = conv_matrix<0>(it, P.cmp_w2 + (size_t)m * 64 * 64, 64, 64, 64, (h16*)(wb + W_C2 + m * W_C2_SZ), scr, lane);
    }
    h16* Hb = (h16*)(P.ws + WS_H);
    { const GAS f32x4* gr = (const GAS f32x4*)P.ng; f32x4 g4[4];
#pragma unroll
      for (int j = 0; j < 2; ++j) { g4[2 * j] = gr[2 * lane + 128 * j]; g4[2 * j + 1] = gr[2 * lane + 1 + 128 * j]; }
      for (int m0 = gw; m0 < T; m0 += 4 * NGW) {
          f32x4 v[4][4];
#pragma unroll
          for (int r = 0; r < 4; ++r) { const int m = m0 + r * NGW; if (m >= T) continue; const GAS f32x4* xr = (const GAS f32x4*)(P.x + (size_t)m * DM);
#pragma unroll
              for (int j = 0; j < 2; ++j) { v[r][2 * j] = xr[2 * lane + 128 * j]; v[r][2 * j + 1] = xr[2 * lane + 1 + 128 * j]; } }
#pragma unroll
          for (int r = 0; r < 4; ++r) { const int m = m0 + r * NGW; if (m >= T) continue; float s = 0.f;
#pragma unroll
              for (int j = 0; j < 4; ++j) s += (v[r][j].x * v[r][j].x + v[r][j].y * v[r][j].y) + (v[r][j].z * v[r][j].z + v[r][j].w * v[r][j].w);
              const float rs = rsqrtf(wave_sum(s) * (1.f / DM) + NORM_EPS);
#pragma unroll
              for (int j = 0; j < 2; ++j) *(GAS u32x4*)(Hb + (size_t)m * DM + 8 * lane + 512 * j) = pkh8(v[r][2 * j] * rs * g4[2 * j], v[r][2 * j + 1] * rs * g4[2 * j + 1]); } } }
    { float* rc = (float*)(P.ws + WS_ROPE_C); float* rs = (float*)(P.ws + WS_ROPE_S);
      for (int i = gw * 64 + lane; i < SEQ * 32; i += NGW * 64) { const int pos = i >> 5, k = i & 31;
          const float inv = (float)pow(10000.0, -(double)k / 32.0); const float ang = (float)pos * inv;
          rc[i] = (float)cos((double)ang); rs[i] = (float)sin((double)ang); } }
    { float* lb = (float*)(P.ws + WS_MISC + 4096);
      for (int i = gw * 64 + lane; i < 1024; i += NGW * 64) { const float l0 = P.hg_lb[i], l1 = P.hg_lb[1024 + i]; const float mx = fmaxf(l0, l1);
          const float e0 = expf(l0 - mx), e1 = expf(l1 - mx); lb[i] = e1 / (e0 + e1); } }
    if (gw < 128) { const int kv = gw >> 6, o = gw & 63; const float* pos = P.cmp_pos + kv * 2048; const float* w1 = P.cmp_w1 + (size_t)kv * 2048 * 64;
        float s = 0.f; for (int k = lane; k < 2048; k += 64) s += pos[k] * w1[(size_t)k * 64 + o];
        s = wave_sum(s); if (lane == 0) ((float*)(P.ws + WS_MISC))[gw] = s; }
}

DI void thin_phase(const float* xin32, float* xout32, h16* x16, const h16* y, const float* gpost, float alpha, const float* gpre, h16* hout, const float* pcv, h16* pdst, int vcu, int G, int wave, int lane) {
    const int gw = vcu * NWAVES + wave, NGW = G * NWAVES;
    f32x4 gp[4], gq[4];
#pragma unroll
    for (int j = 0; j < 2; ++j) { gp[2 * j] = ((const GAS f32x4*)gpost)[2 * lane + 128 * j]; gp[2 * j + 1] = ((const GAS f32x4*)gpost)[2 * lane + 1 + 128 * j];
        if (gpre) { gq[2 * j] = ((const GAS f32x4*)gpre)[2 * lane + 128 * j]; gq[2 * j + 1] = ((const GAS f32x4*)gpre)[2 * lane + 1 + 128 * j]; } }
    for (int m0 = gw; m0 < T; m0 += 4 * NGW) {
        f32x4 xv[4][4], yv[4][4]; f32x4 pv[4]; bool has[4];
#pragma unroll
        for (int r = 0; r < 4; ++r) { const int m = m0 + r * NGW; has[r] = m < T; if (!has[r]) continue;
            const GAS h16x8* yr = (const GAS h16x8*)(y + (size_t)m * DM); const GAS h16x8* x16r = (const GAS h16x8*)(x16 + (size_t)m * DM);
#pragma unroll
            for (int j = 0; j < 2; ++j) { const h16x8 t = yr[lane + 64 * j];
                yv[r][2 * j] = (f32x4){(float)t[0], (float)t[1], (float)t[2], (float)t[3]}; yv[r][2 * j + 1] = (f32x4){(float)t[4], (float)t[5], (float)t[6], (float)t[7]};
                if (xin32) { const GAS f32x4* xi = (const GAS f32x4*)(xin32 + (size_t)m * DM); xv[r][2 * j] = xi[2 * lane + 128 * j]; xv[r][2 * j + 1] = xi[2 * lane + 1 + 128 * j]; }
                else { const h16x8 u = x16r[lane + 64 * j]; xv[r][2 * j] = (f32x4){(float)u[0], (float)u[1], (float)u[2], (float)u[3]}; xv[r][2 * j + 1] = (f32x4){(float)u[4], (float)u[5], (float)u[6], (float)u[7]}; } }
            if (pcv) pv[r] = ((const GAS f32x4*)(pcv + (size_t)m * PLED))[lane]; }
#pragma unroll
        for (int r = 0; r < 4; ++r) { const int m = m0 + r * NGW; if (!has[r]) continue;
            if (pcv) { u32x2 o; o.x = pkh(pv[r].x, pv[r].y); o.y = pkh(pv[r].z, pv[r].w); ((GAS u32x2*)(pdst + (size_t)m * PLED))[lane] = o; }
            float s = 0.f;
#pragma unroll
            for (int j = 0; j < 4; ++j) s += (yv[r][j].x * yv[r][j].x + yv[r][j].y * yv[r][j].y) + (yv[r][j].z * yv[r][j].z + yv[r][j].w * yv[r][j].w);
            const float rr = rsqrtf(wave_sum(s) * (1.f / DM) + NORM_EPS) * alpha; float s2 = 0.f;
#pragma unroll
            for (int j = 0; j < 4; ++j) { xv[r][j] = xv[r][j] + yv[r][j] * rr * gp[j]; s2 += (xv[r][j].x * xv[r][j].x + xv[r][j].y * xv[r][j].y) + (xv[r][j].z * xv[r][j].z + xv[r][j].w * xv[r][j].w); }
#pragma unroll
            for (int j = 0; j < 2; ++j) {
                if (xout32) { GAS f32x4* xr = (GAS f32x4*)(xout32 + (size_t)m * DM); xr[2 * lane + 128 * j] = xv[r][2 * j]; xr[2 * lane + 1 + 128 * j] = xv[r][2 * j + 1]; }
                else st16((GAS h16x8*)(x16 + (size_t)m * DM) + lane + 64 * j, pkh8(xv[r][2 * j], xv[r][2 * j + 1])); }
            if (gpre) { const float r2 = rsqrtf(wave_sum(s2) * (1.f / DM) + NORM_EPS);
#pragma unroll
                for (int j = 0; j < 2; ++j) st16(hout + (size_t)m * DM + 8 * lane + 512 * j, pkh8(xv[r][2 * j] * r2 * gq[2 * j], xv[r][2 * j + 1] * r2 * gq[2 * j + 1])); } }
    }
}

struct EpiPlain {
    static constexpr bool PERM = true, AFTER_DRAIN = false;
    h16* O; int ldc;
    DI void operator()(const f32x4 (&acc)[2][2][4][2], const pg8::Unit& u, int wr, int wc, int fr_, int fq_) const {
        int fr = fr_, fq = fq_; asm volatile("" : "+v"(fr), "+v"(fq));
        const int row0 = u.pm * 256 + wr * 64 + fr, col0 = u.pn * 256 + wc * 32 + 8 * fq;
#pragma unroll
        for (int ai = 0; ai < 2; ++ai)
#pragma unroll
            for (int m = 0; m < 4; ++m) { h16* rowp = O + (size_t)(row0 + ai * 128 + m * 16) * ldc + col0;
#pragma unroll
                for (int bj = 0; bj < 2; ++bj) st16(rowp + bj * 128, pkh8(acc[ai][bj][m][0], acc[ai][bj][m][1])); }
    }
};
struct EpiSwiglu {
    static constexpr bool PERM = true, AFTER_DRAIN = false;
    h16* O;
    DI void operator()(const f32x4 (&acc)[2][2][4][2], const pg8::Unit& u, int wr, int wc, int fr_, int fq_) const {
        int fr = fr_, fq = fq_; asm volatile("" : "+v"(fr), "+v"(fq));
        const int row0 = u.pm * 256 + wr * 64 + fr, col0 = u.pn * 128 + wc * 32 + 8 * fq;
#pragma unroll
        for (int ai = 0; ai < 2; ++ai)
#pragma unroll
            for (int m = 0; m < 4; ++m) { f32x4 v[2];
#pragma unroll
                for (int n = 0; n < 2; ++n)
#pragma unroll
                    for (int i = 0; i < 4; ++i) v[n][i] = siluf_(acc[ai][0][m][n][i]) * acc[ai][1][m][n][i];
                st16(O + (size_t)(row0 + ai * 128 + m * 16) * DFF + col0, pkh8(v[0], v[1])); }
    }
};
struct EpiPleGate {
    static constexpr bool PERM = true, AFTER_DRAIN = false;
    const h16* PE; h16* O;
    DI void operator()(const f32x4 (&acc)[2][2][4][2], const pg8::Unit& u, int wr, int wc, int fr_, int fq_) const {
        int fr = fr_, fq = fq_; asm volatile("" : "+v"(fr), "+v"(fq));
        const int row0 = u.pm * 256 + wr * 64 + fr, col0 = u.pn * 256 + wc * 32 + 8 * fq;
#pragma unroll
        for (int ai = 0; ai < 2; ++ai)
#pragma unroll
            for (int m = 0; m < 4; ++m)
#pragma unroll
                for (int bj = 0; bj < 2; ++bj) { const size_t off = (size_t)(row0 + ai * 128 + m * 16) * DM + col0 + bj * 128;
                    asm volatile("" ::: "memory");
                    const h16x8 pe = *(const GAS h16x8*)(PE + off); f32x4 v[2];
#pragma unroll
                    for (int n = 0; n < 2; ++n)
#pragma unroll
                        for (int i = 0; i < 4; ++i) v[n][i] = (float)pe[4 * n + i] * sigmoidf_(acc[ai][bj][m][n][i]);
                    st16(O + off, pkh8(v[0], v[1])); }
    }
};
struct EpiNsaIn {
    static constexpr bool PERM = true, AFTER_DRAIN = false;
    unsigned char* xb; const float* rc; const float* rs; unsigned* kmax;
    DI void operator()(const f32x4 (&acc)[2][2][4][2], const pg8::Unit& u, int wr, int wc, int fr_, int fq_) const {
        int fr = fr_, fq = fq_; asm volatile("" : "+v"(fr), "+v"(fq));
        const int row0 = u.pm * 256 + wr * 64 + fr; const int pn = u.pn;
        if (pn == 10) {
            float* gt = (float*)(xb + X_GATES); const int j0 = wc * 32 + 8 * fq;
#pragma unroll
            for (int ai = 0; ai < 2; ++ai)
#pragma unroll
                for (int m = 0; m < 4; ++m) { const int row = row0 + ai * 128 + m * 16;
#pragma unroll
                    for (int n = 0; n < 2; ++n) { const int j = j0 + 4 * n; if (j < 48) { f32x4 g;
#pragma unroll
                        for (int i = 0; i < 4; ++i) g[i] = sigmoidf_(acc[ai][0][m][n][i]);
                        *(GAS f32x4*)(gt + (size_t)row * 48 + j) = g; } } }
            return;
        }
        const bool rope = (pn < 4) || pn == 4 || pn == 6 || pn == 8;
        const float sc = (pn < 4) ? 0.125f * LOG2E : 1.0f;
        h16* dst; int ld, colb;
        if (pn < 4) { dst = (h16*)(xb + X_Q); ld = 1024; colb = (4 * pn + wc) * 64; }
        else { dst = (h16*)(xb + X_KC + (size_t)(pn - 4) * 16 * MiB); ld = 64; colb = 0; }
        const int d0 = 8 * fq; float nrm = 0.f;
#pragma unroll
        for (int ai = 0; ai < 2; ++ai)
#pragma unroll
            for (int m = 0; m < 4; ++m) { const int row = row0 + ai * 128 + m * 16;
                asm volatile("" ::: "memory");
                f32x4 o1[2], o2[2];
                if (rope) { const int pos = row & (SEQ - 1);
#pragma unroll
                    for (int n = 0; n < 2; ++n) { const f32x4 c = *(const GAS f32x4*)(rc + pos * 32 + d0 + 4 * n), s = *(const GAS f32x4*)(rs + pos * 32 + d0 + 4 * n);
                        const f32x4 x1 = acc[ai][0][m][n], x2 = acc[ai][1][m][n];
                        o1[n] = (x1 * c - x2 * s) * sc; o2[n] = (x2 * c + x1 * s) * sc; } }
                else { o1[0] = acc[ai][0][m][0]; o1[1] = acc[ai][0][m][1]; o2[0] = acc[ai][1][m][0]; o2[1] = acc[ai][1][m][1]; }
                const size_t rrow = (pn < 4) ? (size_t)row : ((size_t)((row >> 14) * NG + wc) * SEQ + (row & (SEQ - 1)));
                h16* rp = dst + rrow * ld + colb + d0;
                const u32x4 w1 = pkh8(o1[0], o1[1]), w2 = pkh8(o2[0], o2[1]);
                st16(rp, w1); st16(rp + 32, w2);
                if (pn == 6 || pn == 8) {
                    const h16x8 a8 = __builtin_bit_cast(h16x8, w1), b8 = __builtin_bit_cast(h16x8, w2); float s = 0.f;
#pragma unroll
                    for (int i = 0; i < 8; ++i) s += (float)a8[i] * (float)a8[i] + (float)b8[i] * (float)b8[i];
                    s += __shfl_xor(s, 16); s += __shfl_xor(s, 32);
                    nrm = fmaxf(nrm, s); } }
        if (pn == 6 || pn == 8) {
#pragma unroll
            for (int o = 1; o < 16; o <<= 1) nrm = fmaxf(nrm, __shfl_xor(nrm, o));
            if ((fr | fq) == 0) atomicMax(kmax + ((row0 >> 14) * NG + wc) * 2 + (pn == 8 ? 1 : 0), __float_as_uint(nrm)); }
    }
};
struct EpiHgIn {
    static constexpr bool PERM = true, AFTER_DRAIN = false;
    unsigned char* xb; h16* GH; const float* lb;
    DI void operator()(const f32x4 (&acc)[2][2][4][2], const pg8::Unit& u, int wr, int wc, int fr_, int fq_) const {
        int fr = fr_, fq = fq_; asm volatile("" : "+v"(fr), "+v"(fq));
        const int row0 = u.pm * 256 + wr * 64 + fr; const int kind = u.pn >> 2; const int col0 = (u.pn & 3) * 256 + wc * 32 + 8 * fq;
        h16* dst = kind == 0 ? (h16*)(xb + X_QH) : kind == 1 ? (h16*)(xb + X_LF) : kind == 2 ? (h16*)(xb + X_VH) : GH;
        f32x4 lbv[2][2];
        if (kind == 1) {
#pragma unroll
            for (int bj = 0; bj < 2; ++bj)
#pragma unroll
                for (int n = 0; n < 2; ++n) lbv[bj][n] = *(const GAS f32x4*)(lb + col0 + bj * 128 + 4 * n); }
#pragma unroll
        for (int ai = 0; ai < 2; ++ai)
#pragma unroll
            for (int m = 0; m < 4; ++m)
#pragma unroll
                for (int bj = 0; bj < 2; ++bj) { f32x4 v[2];
                    asm volatile("" ::: "memory");
#pragma unroll
                    for (int n = 0; n < 2; ++n)
#pragma unroll
                        for (int i = 0; i < 4; ++i) { const float a = acc[ai][bj][m][n][i]; float r;
                            if (kind == 0 || kind == 3) r = siluf_(a);
                            else if (kind == 1) { const float l = lbv[bj][n][i]; r = __logf(l + (1.f - l) * sigmoidf_(a)); }
                            else r = a;
                            v[n][i] = r; }
                    st16(dst + (size_t)(row0 + ai * 128 + m * 16) * DM + col0 + bj * 128, pkh8(v[0], v[1])); }
    }
};

constexpr int CX_STR = 72;
DI void compress_phase(unsigned char* ws, LAS unsigned char* lds, int wgi, int G, int tid) {
    const int wave = __builtin_amdgcn_readfirstlane(tid >> 6), lane = tid & 63, fr = lane & 15, fq = lane >> 4;
    LAS h16* X = (LAS h16*)lds;
    LAS h16* MID = (LAS h16*)(lds + 528 * CX_STR * 2);
    const int mt = wave >> 2, nt = wave & 3;
    for (int u = wgi; u < 512; u += G) {
        const int kv = u >> 8, b = (u >> 7) & 1, g = (u >> 5) & 3, nb = u & 31, n0 = 32 * nb;
        const h16* src = (const h16*)(ws + WS_X + (kv ? X_VC : X_KC)) + (size_t)(b * NG + g) * SEQ * 64;
        for (int i = tid; i < 528 * 8; i += NTHREADS) { const int r = i >> 3, ch = i & 7; int tok = 16 * n0 + r; tok = tok < SEQ ? tok : SEQ - 1;
            *(LAS u32x4*)(X + r * CX_STR + ch * 8) = *(const GAS u32x4*)(src + (size_t)tok * 64 + ch * 8); }
        __syncthreads();
        const h16* w1t = (const h16*)(ws + WS_W + W_C1 + kv * W_C1_SZ) + (size_t)(16 * nt + fr) * 2048 + 8 * fq;
        f32x4 acc = {0.f, 0.f, 0.f, 0.f};
#pragma unroll 16
        for (int s = 0; s < 64; ++s) {
            const h16x8 a = *(const LAS h16x8*)(X + (16 * (16 * mt + fr) + (s >> 1)) * CX_STR + 32 * (s & 1) + 8 * fq);
            const h16x8 bw = *(const GAS h16x8*)(w1t + 32 * s);
            acc = __builtin_amdgcn_mfma_f32_16x16x32_f16(a, bw, acc, 0, 0, 0);
        }
        const float bias = ((const float*)(ws + WS_MISC))[kv * 64 + 16 * nt + fr];
#pragma unroll
        for (int i = 0; i < 4; ++i) MID[(16 * mt + 4 * fq + i) * CX_STR + 16 * nt + fr] = (h16)siluf_(acc[i] + bias);
        __syncthreads();
        const h16* w2t = (const h16*)(ws + WS_W + W_C2 + kv * W_C2_SZ) + (size_t)(16 * nt + fr) * 64 + 8 * fq;
        f32x4 acc2 = {0.f, 0.f, 0.f, 0.f};
#pragma unroll
        for (int s = 0; s < 2; ++s) {
            const h16x8 a = *(const LAS h16x8*)(MID + (16 * mt + fr) * CX_STR + 32 * s + 8 * fq);
            const h16x8 bw = *(const GAS h16x8*)(w2t + 32 * s);
            acc2 = __builtin_amdgcn_mfma_f32_16x16x32_f16(a, bw, acc2, 0, 0, 0);
        }
        h16* dst = (h16*)(ws + WS_X + (kv ? X_VCMP : X_KCMP)) + (size_t)(b * NG + g) * NCMP_P * 64;
#pragma unroll
        for (int i = 0; i < 4; ++i) { const int n = n0 + 16 * mt + 4 * fq + i; dst[(size_t)n * 64 + 16 * nt + fr] = (n < NCMP) ? (h16)acc2[i] : (h16)0.f; }
        __syncthreads();
    }
}

constexpr int AT_IMP = 49152, AT_SELM = LDSCTL_OFF + 1024, AT_END = AT_SELM + 2048;
static_assert(AT_IMP + 65536 <= RING_BYTES && AT_END <= LDS_BYTES, "attention LDS map");
constexpr float M_INIT = -1e30f, M_MASK = -3e30f;

DI int opaque(int x) { asm volatile("" : "+v"(x)); return x; }
#define WG_BAR() do { asm volatile("s_waitcnt lgkmcnt(0)" ::: "memory"); __builtin_amdgcn_s_barrier(); asm volatile("" ::: "memory"); } while (0)

DI int count_ge4(unsigned k0, unsigned k1, unsigned k2, unsigned k3, unsigned cand) {
    unsigned long long m0, m1, m2, m3;
    asm("v_cmp_le_u32_e64 %0, %4, %5\n\tv_cmp_le_u32_e64 %1, %4, %6\n\tv_cmp_le_u32_e64 %2, %4, %7\n\tv_cmp_le_u32_e64 %3, %4, %8"
        : "=&s"(m0), "=&s"(m1), "=&s"(m2), "=&s"(m3) : "s"(cand), "v"(k0), "v"(k1), "v"(k2), "v"(k3));
    return (__builtin_popcountll(m0) + __builtin_popcountll(m1)) + (__builtin_popcountll(m2) + __builtin_popcountll(m3));
}
DI float quad_sum(float v) {
    v += __builtin_bit_cast(float, __builtin_amdgcn_update_dpp(0, __builtin_bit_cast(int, v), 0xB1, 0xF, 0xF, true));
    v += __builtin_bit_cast(float, __builtin_amdgcn_update_dpp(0, __builtin_bit_cast(int, v), 0x4E, 0xF, 0xF, true));
    return v;
}
DI float col_max(float v) {
    const auto a = __builtin_amdgcn_permlane16_swap(__float_as_uint(v), __float_as_uint(v), false, false);
    const unsigned a0 = a[0], a1 = a[1];
    v = fmaxf(__uint_as_float(a0), __uint_as_float(a1));
    const auto b = __builtin_amdgcn_permlane32_swap(__float_as_uint(v), __float_as_uint(v), false, false);
    const unsigned b0 = b[0], b1 = b[1];
    return fmaxf(__uint_as_float(b0), __uint_as_float(b1));
}
DI float col_sum(float v) { v += __shfl_xor(v, 16); v += __shfl_xor(v, 32); return v; }

DI void glds16(const void* gsrc, unsigned lds_dst) { unsigned keep;
    asm volatile("s_mov_b32 %0, m0\n\ts_mov_b32 m0, %2\n\ts_nop 0\n\tglobal_load_lds_dwordx4 %1, off\n\ts_mov_b32 m0, %0" : "=&s"(keep) : "v"(gsrc), "s"(lds_dst) : "memory"); }
DI void sel_dma_tile(const h16* Kg, const h16* Vg, int ld, int t, LAS unsigned char* slot, int wave, int lane) {
    lane = opaque(lane);
    const int rl = lane >> 3, row = 8 * wave + rl, ch = (lane & 7) ^ rl;
    const unsigned goff = (unsigned)(((64 * t + row) * ld + ch * 8) * 2);
    const unsigned dst = (unsigned)(uintptr_t)(slot + wave * 1024);
    glds16((const char*)Kg + goff, dst);
    glds16((const char*)Vg + goff, dst + 8192u);
}
DI void at_kread(h16x8 (&kf)[8], const LAS h16* Kb, int fr, int fq) {
    const int r7 = fr & 7;
#pragma unroll
    for (int kb = 0; kb < 4; ++kb) { kf[2 * kb] = *(const LAS h16x8*)(Kb + (16 * kb + fr) * 64 + ((fq ^ r7) * 8)); kf[2 * kb + 1] = *(const LAS h16x8*)(Kb + (16 * kb + fr) * 64 + (((4 + fq) ^ r7) * 8)); }
    __builtin_amdgcn_sched_barrier(0);
}
DI void at_qk_mma(f32x4 (&st)[2][4], const h16x8 (&kf)[8], const h16x8 (&qf)[2][2], const float (&bias)[2], bool need0, bool need1) {
#pragma unroll
    for (int kb = 0; kb < 4; ++kb) {
        if (need0) { const f32x4 z = {bias[0], bias[0], bias[0], bias[0]}; st[0][kb] = __builtin_amdgcn_mfma_f32_16x16x32_f16(kf[2 * kb], qf[0][0], z, 0, 0, 0); st[0][kb] = __builtin_amdgcn_mfma_f32_16x16x32_f16(kf[2 * kb + 1], qf[0][1], st[0][kb], 0, 0, 0); }
        if (need1) { const f32x4 z = {bias[1], bias[1], bias[1], bias[1]}; st[1][kb] = __builtin_amdgcn_mfma_f32_16x16x32_f16(kf[2 * kb], qf[1][0], z, 0, 0, 0); st[1][kb] = __builtin_amdgcn_mfma_f32_16x16x32_f16(kf[2 * kb + 1], qf[1][1], st[1][kb], 0, 0, 0); }
    }
}
DI void at_vread(h16x8 (&vf)[8], const LAS h16* Vb, int fr, int fq) {
    const int q = fr >> 2, k7 = 4 * (fq & 1) + q, cl = (fr & 3) >> 1, in4 = 4 * (fr & 1);
#pragma unroll
    for (int s2 = 0; s2 < 2; ++s2)
#pragma unroll
        for (int db = 0; db < 4; ++db) {
            const LAS h16* p0 = Vb + (32 * s2 + 4 * fq + q) * 64 + (((2 * db + cl) ^ k7) * 8) + in4;
            const s16x4 r0 = __builtin_amdgcn_ds_read_tr16_b64_v4i16((LAS s16x4*)p0);
            const s16x4 r1 = __builtin_amdgcn_ds_read_tr16_b64_v4i16((LAS s16x4*)(p0 + 16 * 64));
            vf[4 * s2 + db] = __builtin_bit_cast(h16x8, __builtin_shufflevector(r0, r1, 0, 1, 2, 3, 4, 5, 6, 7)); }
    __builtin_amdgcn_sched_barrier(0);
}
DI void at_pv_mma(f32x4 (&o)[2][4], const h16x8 (&vf)[8], const h16x8 (&pb)[2][2], bool need0, bool need1) {
#pragma unroll
    for (int s2 = 0; s2 < 2; ++s2)
#pragma unroll
        for (int db = 0; db < 4; ++db) {
            if (need0) o[0][db] = __builtin_amdgcn_mfma_f32_16x16x32_f16(vf[4 * s2 + db], pb[0][s2], o[0][db], 0, 0, 0);
            if (need1) o[1][db] = __builtin_amdgcn_mfma_f32_16x16x32_f16(vf[4 * s2 + db], pb[1][s2], o[1][db], 0, 0, 0);
        }
}
DI h16x8 pack_p(const f32x4& a, const f32x4& b) { return __builtin_bit_cast(h16x8, pkh8(a, b)); }
DI void at_expsum(f32x4 (&st)[4], float& lrun, h16x8 (&pb)[2]) {
    float sum = 0.f;
#pragma unroll
    for (int kb = 0; kb < 4; ++kb)
#pragma unroll
        for (int i = 0; i < 4; ++i) { const float pp = __builtin_amdgcn_exp2f(st[kb][i]); st[kb][i] = pp; sum += pp; }
    lrun += sum;
    pb[0] = pack_p(st[0], st[1]); pb[1] = pack_p(st[2], st[3]);
}
#define DN_PIPE_BEGIN(Kg, Vg, ld, first, last)                                                                           \
    { sel_dma_tile(Kg, Vg, ld, (first), lds, wave, lane);                                                                \
      if ((first) + 1 <= (last)) sel_dma_tile(Kg, Vg, ld, (first) + 1, lds + 16384, wave, lane);                         \
      int sl_ = 0;                                                                                                       \
      for (int t_ = (first); t_ <= (last); ++t_) {                                                                       \
          if (t_ + 1 <= (last)) asm volatile("s_waitcnt vmcnt(2)" ::: "memory"); else asm volatile("s_waitcnt vmcnt(0)" ::: "memory");   \
          WG_BAR();                                                                                                      \
          { const int s2_ = sl_ >= 1 ? sl_ - 1 : 2; if (t_ + 2 <= (last)) sel_dma_tile(Kg, Vg, ld, t_ + 2, lds + s2_ * 16384, wave, lane); }   \
          const LAS h16* Kb = (const LAS h16*)(lds + sl_ * 16384); const LAS h16* Vb = Kb + 4096; (void)Vb;
#define DN_PIPE_END                                                                                                      \
          sl_ = sl_ == 2 ? 0 : sl_ + 1; }                                                                                \
      WG_BAR(); }

DI void attn_phase(unsigned char* ws, LAS unsigned char* lds, int wgi, int G, int tid) {
    const int wave = __builtin_amdgcn_readfirstlane(tid >> 6), lane = tid & 63, fr = lane & 15, fq = lane >> 4;
    const int tl = fr >> 2, hd = fr & 3;
    unsigned char* xb = ws + WS_X;
    LAS float* IMP = (LAS float*)(lds + AT_IMP) + wave * (8 * 256);
    LAS unsigned char* sb = (LAS unsigned char*)(lds + AT_SELM) + wave * 256;
    const float* gates = (const float*)(xb + X_GATES);
    for (int u = wgi; u < 2048; u += G) {
        const int bg = u & 7, b = bg >> 2, g = bg & 3, qq = u >> 3, ii = qq >> 5, rr = qq & 31;
        const int r2 = ((ii >> 1) & 1) ? 31 - rr : rr;
        const int c = (ii & 1) ? (64 * (ii >> 1) + 63 - r2) : (64 * (ii >> 1) + r2);
        const size_t rowb = (size_t)b * SEQ;
        const int tw = 64 * c + 8 * wave;
        h16x8 qf[2][2];
#pragma unroll
        for (int a = 0; a < 2; ++a)
#pragma unroll
            for (int s = 0; s < 2; ++s)
                qf[a][s] = *(const GAS h16x8*)((const h16*)(xb + X_Q) + (rowb + tw + 4 * a + tl) * 1024 + (4 * g + hd) * 64 + 32 * s + 8 * fq);
        int tcol[2]; tcol[0] = tw + tl; tcol[1] = tw + 4 + tl;
        asm volatile("" :: "v"(qf[0][0]), "v"(qf[0][1]), "v"(qf[1][0]), "v"(qf[1][1]));
        GAS char* oscr = (GAS char*)(xb + X_OSCR + (size_t)wgi * 65536 + wave * 8192); const unsigned ooff = (unsigned)lane * 128u;
        const float zb[2] = {0.f, 0.f};
        float qn[2];
#pragma unroll
        for (int a = 0; a < 2; ++a) { float s = 0.f;
#pragma unroll
            for (int k2 = 0; k2 < 2; ++k2)
#pragma unroll
                for (int i = 0; i < 8; ++i) s += (float)qf[a][k2][i] * (float)qf[a][k2][i];
            qn[a] = sqrtf(col_sum(s)); }
        const float kmx_s = sqrtf(__uint_as_float(((const unsigned*)(ws + WS_CTL) + CW_KMAX)[(b * NG + g) * 2 + 0])) * 1.002f, kmx_w = sqrtf(__uint_as_float(((const unsigned*)(ws + WS_CTL) + CW_KMAX)[(b * NG + g) * 2 + 1])) * 1.002f;
        {
            const h16* Kg = (const h16*)(xb + X_KCMP) + (size_t)(b * NG + g) * NCMP_P * 64;
            const h16* Vg = (const h16*)(xb + X_VCMP) + (size_t)(b * NG + g) * NCMP_P * 64;
            const int ntc = (4 * c + 3 + 63) >> 6;
            const int tfull = (4 * c - 2 + 1) >> 6;
            int nmax[2];
#pragma unroll
            for (int a = 0; a < 2; ++a) nmax[a] = (tcol[a] >= 31) ? ((tcol[a] - 31) >> 4) : -1;
            f32x4 o[2][4];
#ifndef REP_CMP
#define REP_CMP 1
#endif
            _Pragma("unroll 1") for (int rep_ = 0; rep_ < REP_CMP; ++rep_) {
            float mrun[2] = {M_INIT, M_INIT}, lrun[2] = {0.f, 0.f};
            PROF_BEGIN(1);
            DN_PIPE_BEGIN(Kg, Vg, 64, 0, ntc - 1)
                h16x8 kf[8]; at_kread(kf, Kb, fr, fq); f32x4 st[2][4]; at_qk_mma(st, kf, qf, zb, true, true);
#pragma unroll
                for (int a = 0; a < 2; ++a) {
                    if (t_ >= tfull) {
#pragma unroll
                        for (int kb = 0; kb < 4; ++kb)
#pragma unroll
                            for (int i = 0; i < 4; ++i) { const int n = 64 * t_ + 16 * kb + 4 * fq + i; st[a][kb][i] = (n <= nmax[a]) ? st[a][kb][i] : M_MASK; }
                    }
                    float tmax = fmaxf(fmaxf(fmaxf(st[a][0][0], st[a][0][1]), fmaxf(st[a][0][2], st[a][0][3])), fmaxf(fmaxf(st[a][1][0], st[a][1][1]), fmaxf(st[a][1][2], st[a][1][3])));
                    tmax = fmaxf(tmax, fmaxf(fmaxf(fmaxf(st[a][2][0], st[a][2][1]), fmaxf(st[a][2][2], st[a][2][3])), fmaxf(fmaxf(st[a][3][0], st[a][3][1]), fmaxf(st[a][3][2], st[a][3][3]))));
                    const float mn = fmaxf(mrun[a], tmax); float sum = 0.f;
#pragma unroll
                    for (int kb = 0; kb < 4; ++kb)
#pragma unroll
                        for (int i = 0; i < 4; ++i) sum += __builtin_amdgcn_exp2f(st[a][kb][i] - mn);
                    lrun[a] = lrun[a] * __builtin_amdgcn_exp2f(mrun[a] - mn) + sum; mrun[a] = mn;
                }
            DN_PIPE_END
            PROF_END(1);
            float mcol[2], invl[2];
            PROF_BEGIN(2);
#pragma unroll
            for (int a = 0; a < 2; ++a) { const float mc = col_max(mrun[a]); const float lc = col_sum(lrun[a] * __builtin_amdgcn_exp2f(mrun[a] - mc)); mcol[a] = mc; invl[a] = 1.0f / fmaxf(lc, 1e-30f); }
#pragma unroll
            for (int a = 0; a < 2; ++a)
#pragma unroll
                for (int db = 0; db < 4; ++db) o[a][db] = (f32x4){0.f, 0.f, 0.f, 0.f};
            float carry[2] = {0.f, 0.f};
            const float nb2[2] = {-mcol[0], -mcol[1]};
            DN_PIPE_BEGIN(Kg, Vg, 64, 0, ntc - 1)
                h16x8 kf[8]; at_kread(kf, Kb, fr, fq); f32x4 st[2][4]; at_qk_mma(st, kf, qf, nb2, true, true);
                h16x8 vf[8]; at_vread(vf, Vb, fr, fq);
                h16x8 pb[2][2];
#pragma unroll
                for (int a = 0; a < 2; ++a) {
#pragma unroll
                    for (int kb = 0; kb < 4; ++kb)
#pragma unroll
                        for (int i = 0; i < 4; ++i) { const int n = 64 * t_ + 16 * kb + 4 * fq + i; const float e = __builtin_amdgcn_exp2f(st[a][kb][i]) * invl[a]; st[a][kb][i] = (t_ < tfull || n <= nmax[a]) ? e : 0.f; }
                    pb[a][0] = pack_p(st[a][0], st[a][1]); pb[a][1] = pack_p(st[a][2], st[a][3]);
                    if (c > 15) {
                        const int ln = opaque(lane), fq_ = ln >> 4, hd_ = ln & 3, tl_ = (ln & 15) >> 2;
                        float s4[4], p3[4], tt[4];
#pragma unroll
                        for (int kb = 0; kb < 4; ++kb) { s4[kb] = quad_sum((st[a][kb][0] + st[a][kb][1]) + (st[a][kb][2] + st[a][kb][3])); p3[kb] = quad_sum(st[a][kb][3]); }
#pragma unroll
                        for (int kb = 0; kb < 4; ++kb) tt[kb] = __shfl(p3[kb], (ln + 48) & 63);
#pragma unroll
                        for (int kb = 0; kb < 4; ++kb) { const float recv = (fq_ > 0) ? tt[kb] : (kb > 0 ? tt[kb > 0 ? kb - 1 : 0] : carry[a]);
                            const int j = 16 * t_ + 4 * kb + fq_;
                            if (hd_ == 0 && j < 256) IMP[(4 * a + tl_) * 256 + j] = s4[kb] + recv; }
                        carry[a] = tt[3];
                    }
                }
                at_pv_mma(o, vf, pb, true, true);
            DN_PIPE_END
            }
#pragma unroll
            for (int a = 0; a < 2; ++a) { const float gt = gates[(rowb + tcol[a]) * 48 + (4 * g + hd) * 3 + 0];
#pragma unroll
                for (int db = 0; db < 4; ++db) *(GAS f32x4*)(oscr + (a * 4 + db) * 16 + ooff) = o[a][db] * gt; }
        }
        PROF_END(2);
        PROF_BEGIN(3);
#ifndef REP_TOPK
#define REP_TOPK 1
#endif
        for (int rep_ = 0; rep_ < REP_TOPK; ++rep_) {
            const int lane = opaque(tid) & 63;
            unsigned bytes[4] = {0u, 0u, 0u, 0u};
            if (c <= 15) {
#pragma unroll
                for (int k = 0; k < 4; ++k) bytes[k] = (lane + 64 * k <= c) ? 0xFFu : 0u;
            } else {
#pragma unroll 1
                for (int tk0 = 0; tk0 < 8; tk0 += 8) {
                    unsigned key[8][4];
#pragma unroll
                    for (int q4 = 0; q4 < 8; ++q4)
#pragma unroll
                        for (int k = 0; k < 4; ++k) { const int j = lane + 64 * k; const unsigned ub = __builtin_bit_cast(unsigned, IMP[(tk0 + q4) * 256 + j]);
                            key[q4][k] = (j >= 1 && j <= c - 2) ? (((ub >> 7) << 8) | (unsigned)(255 - j)) : 0u; }
                    unsigned thr[8] = {0u, 0u, 0u, 0u, 0u, 0u, 0u, 0u};
#pragma unroll 1
                    for (int bit = 31; bit >= 8; --bit) {
#pragma unroll
                        for (int q4 = 0; q4 < 8; ++q4) { const unsigned cand = thr[q4] | (1u << bit);
                            if (count_ge4(key[q4][0], key[q4][1], key[q4][2], key[q4][3], cand) >= 13) thr[q4] = cand; } }
                    bool tie = false;
#pragma unroll
                    for (int q4 = 0; q4 < 8; ++q4) tie = tie || (count_ge4(key[q4][0], key[q4][1], key[q4][2], key[q4][3], thr[q4]) != 13);
                    if (tie) {
#pragma unroll 1
                        for (int bit = 7; bit >= 0; --bit) {
#pragma unroll
                            for (int q4 = 0; q4 < 8; ++q4) { const unsigned cand = thr[q4] | (1u << bit);
                                if (count_ge4(key[q4][0], key[q4][1], key[q4][2], key[q4][3], cand) >= 13) thr[q4] = cand; } } }
#pragma unroll
                    for (int q4 = 0; q4 < 8; ++q4)
#pragma unroll
                        for (int k = 0; k < 4; ++k) bytes[k] |= (key[q4][k] >= thr[q4] && key[q4][k] != 0u) ? (1u << (tk0 + q4)) : 0u;
                }
#pragma unroll
                for (int k = 0; k < 4; ++k) { const int j = lane + 64 * k; if (j == 0 || j == c || j == c - 1) bytes[k] = 0xFFu; }
            }
#pragma unroll
            for (int k = 0; k < 4; ++k) sb[lane + 64 * k] = (unsigned char)bytes[k];
        }
        WG_BAR();
        PROF_END(3); PROF_BEGIN(4);
        {
            const h16* Kg = (const h16*)(xb + X_KS) + (size_t)(b * NG + g) * SEQ * 64;
            const h16* Vg = (const h16*)(xb + X_VS) + (size_t)(b * NG + g) * SEQ * 64;
            float lrun[2];
            f32x4 o[2][4];
            const int nblk = c + 1, nbatch = (nblk + 3) >> 2;
#ifndef REP_SEL
#define REP_SEL 1
#endif
            for (int rep_ = 0; rep_ < REP_SEL; ++rep_) {
            lrun[0] = lrun[1] = 0.f;
#pragma unroll
            for (int a = 0; a < 2; ++a)
#pragma unroll
                for (int db = 0; db < 4; ++db) o[a][db] = (f32x4){0.f, 0.f, 0.f, 0.f};
#pragma unroll
            for (int bb = 0; bb < 4; ++bb) if (bb < nblk) sel_dma_tile(Kg, Vg, 64, bb, lds + bb * 16384, wave, lane);
            for (int e = 0; e < nbatch; ++e) {
                PROF_BEGIN(6); asm volatile("s_waitcnt vmcnt(0)" ::: "memory"); PROF_END(6); PROF_BEGIN(7); WG_BAR(); PROF_END(7);
                if (e + 1 < nbatch) {
#pragma unroll
                    for (int bb = 0; bb < 4; ++bb) { const int j = 4 * (e + 1) + bb; if (j < nblk) sel_dma_tile(Kg, Vg, 64, j, lds + (((e + 1) & 1) * 4 + bb) * 16384, wave, lane); } }
#pragma unroll 1
                for (int bb = 0; bb < 4; ++bb) {
                    const int j = 4 * e + bb; if (j >= nblk) break;
                    const unsigned tm = (unsigned)__builtin_amdgcn_readfirstlane((int)sb[j]);
                    const bool need0 = (tm & 0xFu) != 0u, need1 = (tm & 0xF0u) != 0u;
                    if (need0 || need1) {
                        const LAS h16* Kb = (const LAS h16*)(lds + ((e & 1) * 4 + bb) * 16384); const LAS h16* Vb = Kb + 4096;
                        float bias[2];
#pragma unroll
                        for (int a = 0; a < 2; ++a) bias[a] = ((tm >> (4 * a + tl)) & 1u) ? (14.f - qn[a] * kmx_s) : M_MASK;
                        h16x8 kf[8]; at_kread(kf, Kb, fr, fq); f32x4 st[2][4]; at_qk_mma(st, kf, qf, bias, need0, need1);
                        h16x8 vf[8]; at_vread(vf, Vb, fr, fq);
                        h16x8 pb[2][2];
#pragma unroll
                        for (int a = 0; a < 2; ++a) {
                            const bool need = a ? need1 : need0;
                            if (need) {
                                if (j == c) { const int tloc = tcol[a] - 64 * c;
#pragma unroll
                                    for (int kb = 0; kb < 4; ++kb)
#pragma unroll
                                        for (int i = 0; i < 4; ++i) st[a][kb][i] = (16 * kb + 4 * fq + i <= tloc) ? st[a][kb][i] : M_MASK; }
                                at_expsum(st[a], lrun[a], pb[a]);
                            } else { pb[a][0] = (h16x8){0, 0, 0, 0, 0, 0, 0, 0}; pb[a][1] = pb[a][0]; }
                        }
                        at_pv_mma(o, vf, pb, need0, need1);
                    }
                }
            }
            WG_BAR();
            }
#pragma unroll
            for (int a = 0; a < 2; ++a) { const float gt = gates[(rowb + tcol[a]) * 48 + (4 * g + hd) * 3 + 1] / fmaxf(col_sum(lrun[a]), 1e-30f);
#pragma unroll
                for (int db = 0; db < 4; ++db) o[a][db] = o[a][db] * gt; }
            { f32x4 prev[2][4];
#pragma unroll
              for (int a = 0; a < 2; ++a)
#pragma unroll
                for (int db = 0; db < 4; ++db) prev[a][db] = *(const GAS f32x4*)(oscr + (a * 4 + db) * 16 + ooff);
#pragma unroll
              for (int a = 0; a < 2; ++a)
#pragma unroll
                for (int db = 0; db < 4; ++db) *(GAS f32x4*)(oscr + (a * 4 + db) * 16 + ooff) = prev[a][db] + o[a][db]; }
        }
        PROF_END(4); PROF_BEGIN(5);
        {
            const h16* Kg = (const h16*)(xb + X_KW) + (size_t)(b * NG + g) * SEQ * 64;
            const h16* Vg = (const h16*)(xb + X_VW) + (size_t)(b * NG + g) * SEQ * 64;
            float lrun[2];
            f32x4 o[2][4];
            const int j0 = c >= 8 ? c - 8 : 0;
            const float wbias[2] = {14.f - qn[0] * kmx_w, 14.f - qn[1] * kmx_w};
#ifndef REP_WIN
#define REP_WIN 1
#endif
            for (int rep_ = 0; rep_ < REP_WIN; ++rep_) {
            lrun[0] = lrun[1] = 0.f;
#pragma unroll
            for (int a = 0; a < 2; ++a)
#pragma unroll
                for (int db = 0; db < 4; ++db) o[a][db] = (f32x4){0.f, 0.f, 0.f, 0.f};
            DN_PIPE_BEGIN(Kg, Vg, 64, j0, c)
                h16x8 kf[8]; at_kread(kf, Kb, fr, fq); f32x4 st[2][4]; at_qk_mma(st, kf, qf, wbias, true, true);
                h16x8 vf[8]; at_vread(vf, Vb, fr, fq);
                h16x8 pb[2][2];
#pragma unroll
                for (int a = 0; a < 2; ++a) {
                    if (t_ == c || t_ == c - 8) {
#pragma unroll
                        for (int kb = 0; kb < 4; ++kb)
#pragma unroll
                            for (int i = 0; i < 4; ++i) { const int kt = 64 * t_ + 16 * kb + 4 * fq + i; st[a][kb][i] = ((kt <= tcol[a]) && (kt > tcol[a] - 512)) ? st[a][kb][i] : M_MASK; }
                    }
                    at_expsum(st[a], lrun[a], pb[a]);
                }
                at_pv_mma(o, vf, pb, true, true);
            DN_PIPE_END
            }
#pragma unroll
            for (int a = 0; a < 2; ++a) { const float gt = gates[(rowb + tcol[a]) * 48 + (4 * g + hd) * 3 + 2] / fmaxf(col_sum(lrun[a]), 1e-30f);
#pragma unroll
                for (int db = 0; db < 4; ++db) o[a][db] = o[a][db] * gt; }
            { f32x4 prev[2][4];
#pragma unroll
              for (int a = 0; a < 2; ++a)
#pragma unroll
                for (int db = 0; db < 4; ++db) prev[a][db] = *(const GAS f32x4*)(oscr + (a * 4 + db) * 16 + ooff);
#pragma unroll
              for (int a = 0; a < 2; ++a)
#pragma unroll
                for (int db = 0; db < 4; ++db) { const f32x4 ot = prev[a][db] + o[a][db];
                    u32x2 w; w.x = pkh(ot[0], ot[1]); w.y = pkh(ot[2], ot[3]);
                    *(GAS u32x2*)((h16*)(ws + WS_H) + (rowb + tcol[a]) * 1024 + (4 * g + hd) * 64 + 16 * db + 4 * fq) = w; } }
        }
        PROF_END(5);
    }
}

constexpr int HQ_STR = 136;
constexpr int HK_STR = 24;
constexpr int HL_QT = 0, HL_KT = HL_QT + 16 * HQ_STR * 2, HL_KH = HL_KT + 16 * HQ_STR * 2, HL_VT = HL_KH + 128 * HK_STR * 2;
constexpr int HL_DEC = HL_VT + 128 * HK_STR * 2, HL_PART = HL_DEC + 512, HL_RED = HL_PART + 2048, HL_END = HL_RED + 512;
template <bool OUT> DI void hgrn_phase(unsigned char* ws, const float* hg_norm, LAS unsigned char* lds, int wgi, int G, int tid) {
    const int wave = __builtin_amdgcn_readfirstlane(tid >> 6), lane = tid & 63, fr = lane & 15, fq = lane >> 4;
    unsigned char* xb = ws + WS_X;
    LAS __bf16* QT = (LAS __bf16*)(lds + HL_QT); LAS __bf16* KT = (LAS __bf16*)(lds + HL_KT);
    LAS __bf16* KH = (LAS __bf16*)(lds + HL_KH); LAS __bf16* VT = (LAS __bf16*)(lds + HL_VT);
    LAS float* DEC = (LAS float*)(lds + HL_DEC); LAS float* PART = (LAS float*)(lds + HL_PART); LAS float* RED = (LAS float*)(lds + HL_RED);
    const int d = tid & 127, part = tid >> 7;
    float* ST = (float*)(xb + X_ST); float* DT = (float*)(ws + WS_DT);
    for (int u = wgi; u < 256; u += G) {
        const int b = u >> 7, h = (u >> 4) & 7, sc = u & 15;
        const size_t row0 = (size_t)b * SEQ + (size_t)sc * 1024;
        const h16* qg = (const h16*)(xb + X_QH) + row0 * DM + h * 128 + d;
        const h16* fg = (const h16*)(xb + X_LF) + row0 * DM + h * 128 + d;
        const h16* vg = (const h16*)(xb + X_VH) + row0 * DM + h * 128 + d;
        f32x4 S[8];
#pragma unroll
        for (int db = 0; db < 8; ++db) S[db] = (f32x4){0.f, 0.f, 0.f, 0.f};
        if (OUT) {
            for (int i = 0; i < sc; ++i) { const float* st = ST + (size_t)(u - sc + i) * 16384; const float* dt = DT + (size_t)(u - sc + i) * 128;
#pragma unroll
                for (int db = 0; db < 8; ++db) { const f32x4 dv = *(const GAS f32x4*)(dt + 16 * db + 4 * fq);
#pragma unroll
                    for (int k = 0; k < 4; ++k) S[db][k] = S[db][k] * dv[k] + st[(size_t)(16 * db + 4 * fq + k) * 128 + 16 * wave + fr]; } }
        }
        float qv[4], lv[4], vv[4]; float dsum = 0.f;
#pragma unroll
        for (int k = 0; k < 4; ++k) { const size_t o = (size_t)(4 * part + k) * DM; qv[k] = (float)qg[o]; lv[k] = (float)fg[o]; vv[k] = (float)vg[o]; }
        for (int step = 0; step < 64; ++step) {
            float cum[4]; cum[0] = lv[0]; cum[1] = cum[0] + lv[1]; cum[2] = cum[1] + lv[2]; cum[3] = cum[2] + lv[3];
            PART[part * 128 + d] = cum[3];
            WG_BAR();
            float off = 0.f, tot = 0.f;
#pragma unroll
            for (int pp = 0; pp < 4; ++pp) { const float v = PART[pp * 128 + d]; tot += v; if (pp < part) off += v; }
            { b16x4 qt, kt, kh, vt;
#pragma unroll
              for (int k = 0; k < 4; ++k) { const float bt = off + cum[k]; const float kk = -expm1f(lv[k]);
                  const float eb = __expf(bt);
                  if (OUT) { QT[(4 * part + k) * HQ_STR + d] = (__bf16)(qv[k] * eb); KT[(4 * part + k) * HQ_STR + d] = (__bf16)(kk * __expf(fminf(-bt, 80.f))); }
                  kh[k] = (__bf16)(kk * __expf(tot - bt)); vt[k] = (__bf16)vv[k]; }
              *(LAS b16x4*)(KH + d * HK_STR + 4 * part) = kh; *(LAS b16x4*)(VT + d * HK_STR + 4 * part) = vt; }
            if (part == 0) { DEC[d] = __expf(tot); dsum += tot; }
            if (step + 1 < 64) {
#pragma unroll
                for (int k = 0; k < 4; ++k) { const size_t o = (size_t)(16 * (step + 1) + 4 * part + k) * DM; qv[k] = (float)qg[o]; lv[k] = (float)fg[o]; vv[k] = (float)vg[o]; } }
            WG_BAR();
            f32x4 ot = {0.f, 0.f, 0.f, 0.f};
            h16x4 gh = {0, 0, 0, 0}; f32x4 gn = {0.f, 0.f, 0.f, 0.f};
            if (OUT) { gh = *(const GAS h16x4*)((const h16*)(ws + WS_Y) + (row0 + 16 * step + fr) * DM + h * 128 + 16 * wave + 4 * fq); gn = *(const GAS f32x4*)(hg_norm + 16 * wave + 4 * fq); }
            if (OUT) {
                f32x4 at = {0.f, 0.f, 0.f, 0.f};
#pragma unroll
                for (int ks = 0; ks < 4; ++ks) { const b16x8 ka = *(const LAS b16x8*)(KT + fr * HQ_STR + 32 * ks + 8 * fq); const b16x8 qb = *(const LAS b16x8*)(QT + fr * HQ_STR + 32 * ks + 8 * fq);
                    at = __builtin_amdgcn_mfma_f32_16x16x32_bf16(ka, qb, at, 0, 0, 0); }
#pragma unroll
                for (int i = 0; i < 4; ++i) at[i] = (4 * fq + i <= fr) ? at[i] : 0.f;
                { const b16x4 v4 = *(const LAS b16x4*)(VT + (16 * wave + fr) * HK_STR + 4 * fq);
                  const b16x8 va = {v4[0], v4[1], v4[2], v4[3], (__bf16)0.f, (__bf16)0.f, (__bf16)0.f, (__bf16)0.f};
                  u32x4 pw; pw.x = pkb(at[0], at[1]); pw.y = pkb(at[2], at[3]); pw.z = 0u; pw.w = 0u;
                  ot = __builtin_amdgcn_mfma_f32_16x16x32_bf16(va, __builtin_bit_cast(b16x8, pw), ot, 0, 0, 0); }
#pragma unroll
                for (int ks = 0; ks < 4; ++ks) { u32x4 sw; sw.x = pkb(S[2 * ks][0], S[2 * ks][1]); sw.y = pkb(S[2 * ks][2], S[2 * ks][3]); sw.z = pkb(S[2 * ks + 1][0], S[2 * ks + 1][1]); sw.w = pkb(S[2 * ks + 1][2], S[2 * ks + 1][3]);
                    const b16x4 q0 = *(const LAS b16x4*)(QT + fr * HQ_STR + 32 * ks + 4 * fq), q1 = *(const LAS b16x4*)(QT + fr * HQ_STR + 32 * ks + 16 + 4 * fq);
                    const b16x8 qb = {q0[0], q0[1], q0[2], q0[3], q1[0], q1[1], q1[2], q1[3]};
                    ot = __builtin_amdgcn_mfma_f32_16x16x32_bf16(__builtin_bit_cast(b16x8, sw), qb, ot, 0, 0, 0); }
            }
            { b16x8 vb;
              if (fq < 2) vb = *(const LAS b16x8*)(VT + (16 * wave + fr) * HK_STR + 8 * fq); else vb = (b16x8){0, 0, 0, 0, 0, 0, 0, 0};
#pragma unroll
              for (int db = 0; db < 8; ++db) { const f32x4 dv = *(const LAS f32x4*)(DEC + 16 * db + 4 * fq);
                  b16x8 ka; if (fq < 2) ka = *(const LAS b16x8*)(KH + (16 * db + fr) * HK_STR + 8 * fq); else ka = (b16x8){0, 0, 0, 0, 0, 0, 0, 0};
                  S[db] = __builtin_amdgcn_mfma_f32_16x16x32_bf16(ka, vb, S[db] * dv, 0, 0, 0); } }
            if (OUT) {
                float ss = (ot[0] * ot[0] + ot[1] * ot[1]) + (ot[2] * ot[2] + ot[3] * ot[3]);
                ss = col_sum(ss);
                if (fq == 0) RED[wave * 16 + fr] = ss;
                WG_BAR();
                float tots = 0.f;
#pragma unroll
                for (int w2 = 0; w2 < 8; ++w2) tots += RED[w2 * 16 + fr];
                const float rstd = rsqrtf(tots * (1.f / 128.f) + NORM_EPS);
                const size_t orow = row0 + 16 * step + fr; const int ecol = 16 * wave + 4 * fq;
                u32x2 w; w.x = pkh(ot[0] * rstd * gn[0] * (float)gh[0], ot[1] * rstd * gn[1] * (float)gh[1]); w.y = pkh(ot[2] * rstd * gn[2] * (float)gh[2], ot[3] * rstd * gn[3] * (float)gh[3]);
                *(GAS u32x2*)((h16*)(ws + WS_H) + orow * DM + h * 128 + ecol) = w;
            }
        }
        if (!OUT) {
#pragma unroll
            for (int db = 0; db < 8; ++db)
#pragma unroll
                for (int k = 0; k < 4; ++k) ST[(size_t)u * 16384 + (size_t)(16 * db + 4 * fq + k) * 128 + 16 * wave + fr] = S[db][k];
            if (part == 0) DT[(size_t)u * 128 + d] = __expf(dsum);
        }
        __syncthreads();
    }
}

struct Args { Ptrs p; int ph_lo, ph_hi; };
constexpr int N_PHASES = 1 + 4 * 13;
#define NOINL __device__ __forceinline__
typedef const pg8::bf16_t* cbp;
NOINL void site_ffn_in(LAS unsigned char* lds, unsigned char* ws, int widx, int G, int bx, int tid) { asm volatile("" : "+s"(ws));
    pg8::Gemm g{(cbp)(ws + WS_H), (cbp)(ws + WS_W + W_FI + (size_t)widx * W_FI_SZ), T, 2 * DFF, DM, tid}; pg8::StaticOrder S; S.init(T, 2 * DFF, G, bx);
    EpiSwiglu E{(h16*)(ws + WS_X + X_ACT)}; pg8::gemm_phase<EpiSwiglu, pg8::StaticOrder, true, true>(lds, g, S, E); }
NOINL void site_ffn_out(LAS unsigned char* lds, unsigned char* ws, int widx, int G, int bx, int tid) { asm volatile("" : "+s"(ws));
    pg8::Gemm g{(cbp)(ws + WS_X + X_ACT), (cbp)(ws + WS_W + W_FO + (size_t)widx * W_FO_SZ), T, DM, DFF, tid}; pg8::StaticOrder S; S.init(T, DM, G, bx);
    EpiPlain E{(h16*)(ws + WS_Y), DM}; pg8::gemm_phase<EpiPlain, pg8::StaticOrder, true, true>(lds, g, S, E); }
NOINL void site_thin(const float* xin32, float* xout32, unsigned char* ws, const float* gpost, float alpha, const float* gpre, const float* pcv, int G, int bx, int tid) { asm volatile("" : "+s"(ws)); asm volatile("" : "+v"(tid));
    const int vcu = (G % 8 == 0) ? (bx % 8) * (G / 8) + bx / 8 : bx;
    thin_phase(xin32, xout32, (h16*)(ws + WS_X16), (const h16*)(ws + WS_Y), gpost, alpha, gpre, (h16*)(ws + WS_H), pcv, (h16*)(ws + WS_PH), vcu, G, __builtin_amdgcn_readfirstlane(tid >> 6), tid & 63); }
NOINL void site_nsa_in(LAS unsigned char* lds, unsigned char* ws, int G, int bx, int tid) { asm volatile("" : "+s"(ws));
    pg8::Gemm g{(cbp)(ws + WS_H), (cbp)(ws + WS_W + W_NI), T, NSA_NP, DM, tid}; pg8::StaticOrder S; S.init(T, NSA_NP, G, bx);
    EpiNsaIn E{ws + WS_X, (const float*)(ws + WS_ROPE_C), (const float*)(ws + WS_ROPE_S), (unsigned*)(ws + WS_CTL) + CW_KMAX}; pg8::gemm_phase<EpiNsaIn, pg8::StaticOrder, true, true>(lds, g, S, E); }
NOINL void site_cmp(LAS unsigned char* lds, unsigned char* ws, int G, int bx, int tid) { asm volatile("" : "+s"(ws)); asm volatile("" : "+v"(tid)); compress_phase(ws, lds, bx, G, tid); }
NOINL void site_attn(LAS unsigned char* lds, unsigned char* ws, int G, int bx, int tid) { asm volatile("" : "+s"(ws)); asm volatile("" : "+v"(tid)); attn_phase(ws, lds, bx, G, tid); }
NOINL void site_hg_in(LAS unsigned char* lds, unsigned char* ws, int G, int bx, int tid) { asm volatile("" : "+s"(ws));
    pg8::Gemm g{(cbp)(ws + WS_H), (cbp)(ws + WS_W + W_HI), T, 4096, DM, tid}; pg8::StaticOrder S; S.init(T, 4096, G, bx);
    EpiHgIn E{ws + WS_X, (h16*)(ws + WS_Y), (const float*)(ws + WS_MISC + 4096)}; pg8::gemm_phase<EpiHgIn, pg8::StaticOrder, true, true>(lds, g, S, E); }
NOINL void site_hg_a(LAS unsigned char* lds, unsigned char* ws, int G, int bx, int tid) { asm volatile("" : "+s"(ws)); asm volatile("" : "+v"(tid)); hgrn_phase<false>(ws, nullptr, lds, bx, G, tid); }
NOINL void site_hg_b(LAS unsigned char* lds, unsigned char* ws, const float* hg_norm, int G, int bx, int tid) { asm volatile("" : "+s"(ws)); asm volatile("" : "+v"(tid)); hgrn_phase<true>(ws, hg_norm, lds, bx, G, tid); }
NOINL void site_mix_out(LAS unsigned char* lds, unsigned char* ws, size_t woff, int G, int bx, int tid) { asm volatile("" : "+s"(ws));
    pg8::Gemm g{(cbp)(ws + WS_H), (cbp)(ws + WS_W + woff), T, DM, DM, tid}; pg8::StaticOrder S; S.init(T, DM, G, bx);
    EpiPlain E{(h16*)(ws + WS_Y), DM}; pg8::gemm_phase<EpiPlain, pg8::StaticOrder, true, true>(lds, g, S, E); }
NOINL void site_ple_pe(LAS unsigned char* lds, unsigned char* ws, int l, int G, int bx, int tid) { asm volatile("" : "+s"(ws));
    int kk = PLED; asm volatile("" : "+s"(kk));
    pg8::Gemm g{(cbp)(ws + WS_PH), (cbp)(ws + WS_W + W_PI + (size_t)l * W_PI_SZ), T, DM, kk, tid}; pg8::StaticOrder S; S.init(T, DM, G, bx);
    EpiPlain E{(h16*)(ws + WS_X + X_PE), DM}; pg8::gemm_phase<EpiPlain, pg8::StaticOrder, true, true>(lds, g, S, E); }
NOINL void site_ple_gate(LAS unsigned char* lds, unsigned char* ws, int l, int G, int bx, int tid) { asm volatile("" : "+s"(ws));
    pg8::Gemm g{(cbp)(ws + WS_H), (cbp)(ws + WS_W + W_PG + (size_t)l * W_SQ_SZ), T, DM, DM, tid}; pg8::StaticOrder S; S.init(T, DM, G, bx);
    EpiPleGate E{(const h16*)(ws + WS_X + X_PE), (h16*)(ws + WS_Y)}; pg8::gemm_phase<EpiPleGate, pg8::StaticOrder, true, true>(lds, g, S, E); }

DI int lane_id_now() { int x; asm volatile("v_mbcnt_lo_u32_b32 %0, -1, 0\n\tv_mbcnt_hi_u32_b32 %0, -1, %0" : "=v"(x)); return x; }
__global__ void __launch_bounds__(NTHREADS, 2) fwd_kernel(Args args) {
    extern __shared__ __attribute__((aligned(16))) unsigned char lds_raw[];
    LAS unsigned char* lds = (LAS unsigned char*)lds_raw;
    const int wave_s = __builtin_amdgcn_readfirstlane((int)threadIdx.x >> 6);
#define tid ((wave_s << 6) | lane_id_now())
    const int G = gridDim.x, bx = blockIdx.x;
    if ((int)threadIdx.x < 32) ((LAS unsigned*)(lds + LDSCTL_OFF))[threadIdx.x] = 0u;
    __syncthreads();
    unsigned char* ws = args.p.ws;
    XcdBarrier bar = xcd_barrier_post((unsigned*)(ws + WS_CTL) + CW_BAR, (volatile LAS unsigned*)(lds + LDSCTL_OFF));
    const int lo = args.ph_lo, hi = args.ph_hi;
    int ph = 0;
#ifndef ENMASK
#define ENMASK 0xFFFF
#endif
#define EN(j) ((ENMASK >> (j)) & 1)
#define RUN(k) ((k) >= lo && (k) < hi)
#define SEAM(k) do { if (RUN(k) && RUN((k) + 1)) { PROF_BEGIN(200); xcd_barrier(bar); PROF_END(200); } } while (0)
    PROF_BEGIN(99);
    if (EN(0) && RUN(0)) { const int vcu = (G % 8 == 0) ? (bx % 8) * (G / 8) + bx / 8 : bx; p0_prologue(args.p, lds, vcu, G, __builtin_amdgcn_readfirstlane(tid >> 6), tid & 63); }
    PROF_END(99);
    SEAM(0);
#pragma unroll 1
    for (int hs = 0; hs < 2 * DEPTH; ++hs) {
        const int l = hs >> 1, second = hs & 1, base = 1 + hs * 13;
        const float* ng = args.p.ng + (size_t)l * 8 * DM;
        ph = base + 0; PROF_BEGIN(100); if (EN(1) && RUN(ph)) { site_ffn_in(lds, ws, 2 * l + second, G, bx, tid);
#ifdef DUP_FFNIN
 __syncthreads(); site_ffn_in(lds, ws, 2 * l + second, G, bx, tid);
#endif
 } PROF_END(ph - base + 100); SEAM(ph);
        ph = base + 1; PROF_BEGIN(101); if (EN(2) && RUN(ph)) site_ffn_out(lds, ws, 2 * l + second, G, bx, tid); PROF_END(ph - base + 100); SEAM(ph);
        ph = base + 2; PROF_BEGIN(102); if (EN(3) && RUN(ph)) site_thin(hs == 0 ? args.p.x : nullptr, nullptr, ws, ng + (second ? 5 : 1) * DM, 0.5f, ng + (second ? 6 : 2) * DM, second ? args.p.p + (size_t)l * T * PLED : nullptr, G, bx, tid); PROF_END(ph - base + 100); SEAM(ph);
        if (!second) {
            if (l == 0) {
                ph = base + 3; PROF_BEGIN(103); if (EN(4) && RUN(ph)) site_nsa_in(lds, ws, G, bx, tid); PROF_END(ph - base + 100); SEAM(ph);
                ph = base + 4; PROF_BEGIN(104); if (EN(5) && RUN(ph)) { site_cmp(lds, ws, G, bx, tid);
#ifdef DUP_CMP
 __syncthreads(); site_cmp(lds, ws, G, bx, tid);
#endif
 } PROF_END(ph - base + 100); SEAM(ph);
                ph = base + 5; PROF_BEGIN(105); if (EN(6) && RUN(ph)) { site_attn(lds, ws, G, bx, tid);
#ifdef DUP_ATT
 __syncthreads(); site_attn(lds, ws, G, bx, tid);
#endif
 } PROF_END(ph - base + 100); SEAM(ph);
            } else {
                ph = base + 6; PROF_BEGIN(106); if (EN(7) && RUN(ph)) site_hg_in(lds, ws, G, bx, tid); PROF_END(ph - base + 100); SEAM(ph);
                ph = base + 7; PROF_BEGIN(107); if (EN(8) && RUN(ph)) { site_hg_a(lds, ws, G, bx, tid);
#ifdef DUP_HGA
 __syncthreads(); site_hg_a(lds, ws, G, bx, tid);
#endif
 } PROF_END(ph - base + 100); SEAM(ph);
                ph = base + 8; PROF_BEGIN(108); if (EN(9) && RUN(ph)) { site_hg_b(lds, ws, args.p.hg_norm, G, bx, tid);
#ifdef DUP_HGB
 __syncthreads(); site_hg_b(lds, ws, args.p.hg_norm, G, bx, tid);
#endif
 } PROF_END(ph - base + 100); SEAM(ph);
            }
            ph = base + 9; PROF_BEGIN(109); if (EN(10) && RUN(ph)) site_mix_out(lds, ws, l == 0 ? W_NO : W_HO, G, bx, tid); PROF_END(ph - base + 100); SEAM(ph);
            ph = base + 10; PROF_BEGIN(110); if (EN(11) && RUN(ph)) site_thin(nullptr, nullptr, ws, ng + 3 * DM, 1.0f, ng + 4 * DM, nullptr, G, bx, tid); PROF_END(ph - base + 100); SEAM(ph);
        } else {
            ph = base + 11; PROF_BEGIN(111); if (EN(12) && RUN(ph)) {
#ifndef NO_PE
 site_ple_pe(lds, ws, l, G, bx, tid);
#endif
 asm volatile("s_waitcnt vmcnt(0)" ::: "memory"); __syncthreads();
#ifndef NO_GATE
 site_ple_gate(lds, ws, l, G, bx, tid);
#endif
 } PROF_END(ph - base + 100); SEAM(ph);
            ph = base + 12; PROF_BEGIN(112); if (EN(13) && RUN(ph)) site_thin(nullptr, (l + 1 < DEPTH) ? nullptr : args.p.out, ws, ng + 7 * DM, 1.0f, (l + 1 < DEPTH) ? args.p.ng + (size_t)(l + 1) * 8 * DM : nullptr, nullptr, G, bx, tid); PROF_END(ph - base + 100); SEAM(ph);
        }
    }
#ifdef PROF
    xcd_barrier(bar);
    if (threadIdx.x == 0) { const float tt = (float)*(LAS unsigned long long*)(lds + PROF_ACC);
#ifdef PROF_MIN
        args.p.out[bx] += 200000.0f / fmaxf(tt, 1.f);
#else
        args.p.out[bx] += tt * (1.0f / 20000.0f);
#endif
    }
#endif
#undef RUN
#undef SEAM
#undef tid
}

#ifndef MK_PER_PHASE
#define MK_PER_PHASE 0
#endif
extern "C" void kernel_launch(void* const* d_in, const int* in_sizes, int n_in, void* d_out, int out_size, void* d_ws, size_t ws_size, hipStream_t stream) {
    static int grid = 0;
    if (grid == 0) {
        if (n_in != 16 || in_sizes[0] != T * DM || out_size != T * DM || ws_size < WS_END) { fprintf(stderr, "kernel_launch: unexpected shapes / workspace (%d inputs, ws %zu)\n", n_in, ws_size); grid = -1; return; }
        int dev = 0, cus = 0, per_cu = 0;
        if (hipGetDevice(&dev) != hipSuccess || hipDeviceGetAttribute(&cus, hipDeviceAttributeMultiprocessorCount, dev) != hipSuccess) { grid = -1; return; }
        if (hipFuncSetAttribute((const void*)fwd_kernel, hipFuncAttributeMaxDynamicSharedMemorySize, LDS_BYTES) != hipSuccess) { grid = -1; return; }
        if (hipOccupancyMaxActiveBlocksPerMultiprocessor(&per_cu, (const void*)fwd_kernel, NTHREADS, LDS_BYTES) != hipSuccess || per_cu < 1) { fprintf(stderr, "kernel_launch: occupancy query says %d\n", per_cu); }
        (void)hipGetLastError();
        grid = cus;
    }
    if (grid < 0) return;
    if (hipMemsetAsync((char*)d_ws + WS_CTL, 0, CTL_ZERO_BYTES, stream) != hipSuccess) return;
    Args a{};
    const float* const* in = (const float* const*)d_in;
    a.p.x = in[0]; a.p.p = in[1]; a.p.ng = in[2]; a.p.ffn_in = in[3]; a.p.ffn_out = in[4]; a.p.ple_in = in[5]; a.p.ple_gate = in[6]; a.p.nsa_in = in[7]; a.p.nsa_out = in[8];
    a.p.cmp_pos = in[9]; a.p.cmp_w1 = in[10]; a.p.cmp_w2 = in[11]; a.p.hg_in = in[12]; a.p.hg_out = in[13]; a.p.hg_norm = in[14]; a.p.hg_lb = in[15];
    a.p.out = (float*)d_out; a.p.ws = (unsigned char*)d_ws;
#if MK_PER_PHASE
    for (int k = 0; k < N_PHASES; ++k) { a.ph_lo = k; a.ph_hi = k + 1; hipLaunchKernelGGL(fwd_kernel, dim3(grid), dim3(NTHREADS), LDS_BYTES, stream, a); }
#else
    a.ph_lo = 0; a.ph_hi = N_PHASES;
    hipLaunchKernelGGL(fwd_kernel, dim3(grid), dim3(NTHREADS), LDS_BYTES, stream, a);
#endif
}
```
